# Optimizing an MI355X kernel written in HIP

```python
import jax, jax.numpy as jnp
from jax import lax
import numpy as np

D_MODEL = 1024
BATCH = 16
SEQ = 256
DEPTH = 4
DEC_BATCH = 8
DEC_SEQ = 2048
PAST_LEN = 256

GRID_W = 64
HEAD_DIM = 64
EPS = 1e-6
NA_HEADS = 8
NA_WIDTH = NA_HEADS * HEAD_DIM
NA_KR = 8
NA_KC = 16
GLA_HEADS = 4
GLA_DK = 64
GLA_DV = 128
GLA_KW = GLA_HEADS * GLA_DK
GLA_VW = GLA_HEADS * GLA_DV
GLA_RANK = 16
GLA_GATE_NORM = 16.0
GLA_CHUNK = 64
GQA_HEADS = 16
GQA_KV_HEADS = 4
GQA_GROUP = GQA_HEADS // GQA_KV_HEADS
C_QW = GQA_HEADS * HEAD_DIM
C_KW = GQA_KV_HEADS * HEAD_DIM
C_IN = C_QW + 2 * C_KW
ROPE_THETA = 10000.0
ROPE_AXIS_DIM = HEAD_DIM // 2
Q_BLOCK = 128
D_FF = 2816
CONV_W = 3
N_AB = (DEPTH + 1) // 2
N_C = DEPTH // 2
AB_IN = 3 * NA_WIDTH + 2 * GLA_KW + 2 * GLA_VW + 2 * GLA_RANK
AB_OUT = NA_WIDTH + GLA_VW
AB_SPLITS = (NA_WIDTH, 2 * NA_WIDTH, 3 * NA_WIDTH,
             3 * NA_WIDTH + GLA_KW, 3 * NA_WIDTH + 2 * GLA_KW,
             3 * NA_WIDTH + 2 * GLA_KW + GLA_VW, 3 * NA_WIDTH + 2 * GLA_KW + 2 * GLA_VW,
             3 * NA_WIDTH + 2 * GLA_KW + 2 * GLA_VW + GLA_RANK)

kernel_name = "hybrid_na_gla_gqa_prefix_dit_step"


def rms_norm(x, g):
    xf = x.astype(jnp.float32)
    xf = xf * lax.rsqrt(jnp.mean(xf * xf, axis=-1, keepdims=True) + EPS)
    return (xf * g.astype(jnp.float32)).astype(x.dtype)


def heads(a, nh):
    b, n, w = a.shape
    return a.reshape(b, n, nh, w // nh).transpose(0, 2, 1, 3)


def merge(a):
    b, h, n, d = a.shape
    return a.transpose(0, 2, 1, 3).reshape(b, n, h * d)


def modulation(cvec, w, bias):
    mod = (jax.nn.silu(cvec) @ w + bias).reshape(-1, 1, 6 * D_MODEL)
    return jnp.split(mod, 6, axis=-1)


def block_attention(q, k, v):
    b, kvh, g, nq, d = q.shape
    nb = nq // Q_BLOCK
    qb = jnp.moveaxis(q.reshape(b, kvh, g, nb, Q_BLOCK, d), 3, 0)
    scale = d ** -0.5

    def one(qblk):
        s = jnp.einsum('bhgqd,bhkd->bhgqk', qblk, k).astype(jnp.float32) * scale
        p = jax.nn.softmax(s, axis=-1).astype(v.dtype)
        return jnp.einsum('bhgqk,bhkd->bhgqd', p, v)

    o = lax.map(one, qb)
    return jnp.moveaxis(o, 0, 3).reshape(b, kvh, g, nq, d)


def grid_angles(n):
    t = jnp.arange(n)
    row = (t // GRID_W).astype(jnp.float32)
    col = (t % GRID_W).astype(jnp.float32)
    inv = ROPE_THETA ** (-jnp.arange(0, ROPE_AXIS_DIM, 2, dtype=jnp.float32) / ROPE_AXIS_DIM)
    return row[:, None] * inv, col[:, None] * inv


def rope_half(x, ang):
    x1, x2 = jnp.split(x, 2, axis=-1)
    cos, sin = jnp.cos(ang).astype(x.dtype), jnp.sin(ang).astype(x.dtype)
    return jnp.concatenate([x1 * cos - x2 * sin, x2 * cos + x1 * sin], axis=-1)


def rope_2d(x, ang_r, ang_c):
    xr, xc = jnp.split(x, 2, axis=-1)
    return jnp.concatenate([rope_half(xr, ang_r), rope_half(xc, ang_c)], axis=-1)


def neighbourhood_attention(q, k, v, k_ctx, v_ctx, rpb):
    b, h, n, d = q.shape
    rows = n // GRID_W
    kr = min(NA_KR, rows)
    r = jnp.arange(rows)
    rs = jnp.clip(r - kr // 2, 0, rows - kr)
    key_rows = rs[:, None] + jnp.arange(kr)[None, :]
    col = jnp.arange(GRID_W)
    cs = jnp.clip(col - NA_KC // 2, 0, GRID_W - NA_KC)
    col_ok = (col[None, :] >= cs[:, None]) & (col[None, :] < cs[:, None] + NA_KC)
    mask = jnp.broadcast_to(col_ok[:, None, :], (GRID_W, kr, GRID_W)).reshape(GRID_W, kr * GRID_W)
    qg = q.reshape(b, h, rows, GRID_W, d)
    kg = k.reshape(b, h, rows, GRID_W, d)[:, :, key_rows].reshape(b, h, rows, kr * GRID_W, d)
    vg = v.reshape(b, h, rows, GRID_W, d)[:, :, key_rows].reshape(b, h, rows, kr * GRID_W, d)
    dr = key_rows - r[:, None] + NA_KR - 1
    dc = jnp.clip(col[None, :] - col[:, None] + NA_KC - 1, 0, 2 * NA_KC - 2)
    bias = rpb.astype(jnp.float32)[:, dr[:, None, :, None], dc[None, :, None, :]]
    bias = bias.reshape(h, rows, GRID_W, kr * GRID_W)
    scale = d ** -0.5
    s_loc = jnp.einsum('bhrqd,bhrkd->bhrqk', qg, kg).astype(jnp.float32) * scale + bias
    s_loc = jnp.where(mask, s_loc, -jnp.inf)
    s_ctx = jnp.einsum('bhrqd,bhld->bhrql', qg, k_ctx).astype(jnp.float32) * scale
    p = jax.nn.softmax(jnp.concatenate([s_loc, s_ctx], axis=-1), axis=-1).astype(v.dtype)
    nk = kr * GRID_W
    o = (jnp.einsum('bhrqk,bhrkd->bhrqd', p[..., :nk], vg)
         + jnp.einsum('bhrql,bhld->bhrqd', p[..., nk:], v_ctx))
    return o.reshape(b, h, n, d)


def gla_scan(q, k, v, g, s0):
    b, h, t, dk = q.shape
    dv = v.shape[-1]
    nc = t // GLA_CHUNK

    def chunks(a):
        return jnp.moveaxis(a.reshape(b, h, nc, GLA_CHUNK, a.shape[-1]), 2, 0)

    causal = jnp.tril(jnp.ones((GLA_CHUNK, GLA_CHUNK), dtype=bool))

    def step(s, inp):
        qc, kc, vc, gc = inp
        bcum = jnp.cumsum(gc.astype(jnp.float32), axis=2)
        o_inter = jnp.einsum('bhid,bhde->bhie', qc * jnp.exp(bcum).astype(qc.dtype), s)
        diff = bcum[:, :, :, None, :] - bcum[:, :, None, :, :]
        decay = jnp.exp(jnp.where(causal[:, :, None], diff, -jnp.inf)).astype(qc.dtype)
        att = jnp.einsum('bhid,bhjd,bhijd->bhij', qc, kc, decay)
        o = o_inter + jnp.einsum('bhij,bhje->bhie', att, vc)
        blast = bcum[:, :, -1:, :]
        k_dec = kc * jnp.exp(blast - bcum).astype(kc.dtype)
        s_new = (jnp.exp(blast[:, :, 0, :])[..., None].astype(s.dtype) * s
                 + jnp.einsum('bhjd,bhje->bhde', k_dec, vc)).astype(s.dtype)
        return s_new, o

    s_fin, o = lax.scan(step, s0, (chunks(q), chunks(k), chunks(v), chunks(g)))
    return jnp.moveaxis(o, 0, 2).reshape(b, h, t, dv), s_fin


def gla_bidir(q, k, v, g_f, g_b, s0_f, s0_b):
    o_f, s_f = gla_scan(q, k, v, g_f, s0_f)
    flip = lambda a: jnp.flip(a, axis=2)
    o_b, s_b = gla_scan(flip(q), flip(k), flip(v), flip(g_b), s0_b)
    return o_f + flip(o_b), s_f, s_b


def ab_mixer(h, w_in, w_out, rpb, w2_f, b2_f, w2_b, b2_b, gla_g, ctx):
    b, n, _ = h.shape
    qa, ka, va, qg, kg, vg, rg, lr_f, lr_b = jnp.split(h @ w_in, AB_SPLITS, axis=-1)
    qa, ka, va = heads(qa, NA_HEADS), heads(ka, NA_HEADS), heads(va, NA_HEADS)
    qg = heads(qg, GLA_HEADS) * (GLA_DK ** -0.5)
    kg, vg = heads(kg, GLA_HEADS), heads(vg, GLA_HEADS)
    gf = heads(jax.nn.log_sigmoid(lr_f @ w2_f + b2_f) / GLA_GATE_NORM, GLA_HEADS)
    gb = heads(jax.nn.log_sigmoid(lr_b @ w2_b + b2_b) / GLA_GATE_NORM, GLA_HEADS)
    if ctx is None:
        oa = block_attention(qa[:, :, None], ka, va)[:, :, 0]
        zeros = jnp.zeros((b, GLA_HEADS, GLA_DK, GLA_DV), h.dtype)
        og, s_f, s_b = gla_bidir(qg, kg, vg, gf, gb, zeros, zeros)
        new = (ka, va, s_f, s_b)
    else:
        k_ctx, v_ctx, s0_f, s0_b = ctx
        oa = neighbourhood_attention(qa, ka, va, k_ctx, v_ctx, rpb)
        og, _, _ = gla_bidir(qg, kg, vg, gf, gb, s0_f, s0_b)
        new = None
    og = merge(rms_norm(og, gla_g.reshape(GLA_HEADS, 1, GLA_DV))) * jax.nn.silu(rg)
    out = jnp.concatenate([merge(oa), og], axis=-1) @ w_out
    return out, new


def c_mixer(h, w_in, w_out, qn_g, kn_g, ctx):
    b, n, _ = h.shape
    q, k, v = jnp.split(h @ w_in, (C_QW, C_QW + C_KW), axis=-1)
    q = rms_norm(heads(q, GQA_HEADS), qn_g)
    k = rms_norm(heads(k, GQA_KV_HEADS), kn_g)
    v = heads(v, GQA_KV_HEADS)
    if ctx is None:
        o = block_attention(q.reshape(b, GQA_KV_HEADS, GQA_GROUP, n, HEAD_DIM), k, v)
        new = (k, v)
    else:
        k_ctx, v_ctx = ctx
        ang_r, ang_c = grid_angles(n)
        q = rope_2d(q, ang_r, ang_c)
        k = rope_2d(k, ang_r, ang_c)
        k_all = jnp.concatenate([k, k_ctx], axis=2)
        v_all = jnp.concatenate([v, v_ctx], axis=2)
        o = block_attention(q.reshape(b, GQA_KV_HEADS, GQA_GROUP, n, HEAD_DIM), k_all, v_all)
        new = None
    return merge(o.reshape(b, GQA_HEADS, n, HEAD_DIM)) @ w_out, new


def conv_ffn(h, w_up, conv_w, conv_b, w_down):
    u = h @ w_up
    up = jnp.pad(u, ((0, 0), (1, 1), (0, 0)))
    u = up[:, :-2] * conv_w[0] + up[:, 1:-1] * conv_w[1] + up[:, 2:] * conv_w[2] + conv_b
    val, gate = jnp.split(u, 2, axis=-1)
    return (jax.nn.silu(gate) * val) @ w_down


def setup_inputs(seed: int = 0) -> dict:
    key = jax.random.key(seed)
    ks = jax.random.split(key, 40)
    nrm = lambda i, shape, s=1.0: jax.random.normal(ks[i], shape, jnp.float32) * s
    D = D_MODEL
    return {
        "x_prompt": nrm(0, (BATCH, SEQ, D)),
        "x_sample": nrm(1, (DEC_BATCH, DEC_SEQ, D)),
        "cache_na_k": nrm(2, (DEC_BATCH, N_AB, NA_HEADS, PAST_LEN, HEAD_DIM)),
        "cache_na_v": nrm(3, (DEC_BATCH, N_AB, NA_HEADS, PAST_LEN, HEAD_DIM)),
        "state_gla_fwd": nrm(4, (DEC_BATCH, N_AB, GLA_HEADS, GLA_DK, GLA_DV)),
        "state_gla_bwd": nrm(5, (DEC_BATCH, N_AB, GLA_HEADS, GLA_DK, GLA_DV)),
        "cache_gqa_k": nrm(6, (DEC_BATCH, N_C, GQA_KV_HEADS, PAST_LEN, HEAD_DIM)),
        "cache_gqa_v": nrm(7, (DEC_BATCH, N_C, GQA_KV_HEADS, PAST_LEN, HEAD_DIM)),
        "c": nrm(8, (DEC_BATCH, D)),
        "c_ctx": nrm(9, (D,)),
        "ada_w": nrm(10, (DEPTH, D, 6 * D), 0.5 * D ** -0.5),
        "ada_b": nrm(11, (DEPTH, 6 * D), 0.02),
        "norm_mix_g": 1.0 + nrm(12, (DEPTH, D), 0.1),
        "norm_ffn_g": 1.0 + nrm(13, (DEPTH, D), 0.1),
        "ab_w_in": nrm(14, (N_AB, D, AB_IN), D ** -0.5),
        "ab_w_out": nrm(15, (N_AB, AB_OUT, D), AB_OUT ** -0.5),
        "na_rpb": nrm(16, (N_AB, NA_HEADS, 2 * NA_KR - 1, 2 * NA_KC - 1), 0.2),
        "gla_w2_fwd": nrm(17, (N_AB, GLA_RANK, GLA_KW), GLA_RANK ** -0.5),
        "gla_b2_fwd": nrm(18, (N_AB, GLA_KW), 0.5),
        "gla_w2_bwd": nrm(19, (N_AB, GLA_RANK, GLA_KW), GLA_RANK ** -0.5),
        "gla_b2_bwd": nrm(20, (N_AB, GLA_KW), 0.5),
        "gla_norm_g": 1.0 + nrm(21, (N_AB, GLA_VW), 0.1),
        "gqa_w_in": nrm(22, (N_C, D, C_IN), D ** -0.5),
        "gqa_w_out": nrm(23, (N_C, C_QW, D), C_QW ** -0.5),
        "gqa_q_norm_g": 1.0 + nrm(24, (N_C, HEAD_DIM), 0.1),
        "gqa_k_norm_g": 1.0 + nrm(25, (N_C, HEAD_DIM), 0.1),
        "ffn_w_up": nrm(26, (DEPTH, D, 2 * D_FF), D ** -0.5),
        "ffn_conv_w": nrm(27, (DEPTH, CONV_W, 2 * D_FF), CONV_W ** -0.5),
        "ffn_conv_b": nrm(28, (DEPTH, 2 * D_FF), 0.02),
        "ffn_w_down": nrm(29, (DEPTH, D_FF, D), D_FF ** -0.5),
        "final_norm_g": 1.0 + nrm(30, (D,), 0.1),
    }


def reference(x_prompt, x_sample, cache_na_k, cache_na_v, state_gla_fwd, state_gla_bwd,
              cache_gqa_k, cache_gqa_v, c, c_ctx, ada_w, ada_b, norm_mix_g, norm_ffn_g,
              ab_w_in, ab_w_out, na_rpb, gla_w2_fwd, gla_b2_fwd, gla_w2_bwd, gla_b2_bwd, gla_norm_g,
              gqa_w_in, gqa_w_out, gqa_q_norm_g, gqa_k_norm_g,
              ffn_w_up, ffn_conv_w, ffn_conv_b, ffn_w_down, final_norm_g):
    xp, xs = x_prompt, x_sample
    na_k, na_v, gla_f, gla_b, gq_k, gq_v = [], [], [], [], [], []
    for i in range(DEPTH):
        j = i // 2
        sh1p, sc1p, g1p, sh2p, sc2p, g2p = modulation(c_ctx, ada_w[i], ada_b[i])
        sh1s, sc1s, g1s, sh2s, sc2s, g2s = modulation(c, ada_w[i], ada_b[i])
        hp = rms_norm(xp, norm_mix_g[i]) * (1.0 + sc1p) + sh1p
        hs = rms_norm(xs, norm_mix_g[i]) * (1.0 + sc1s) + sh1s
        if i % 2 == 0:
            prm = (ab_w_in[j], ab_w_out[j], na_rpb[j], gla_w2_fwd[j], gla_b2_fwd[j],
                   gla_w2_bwd[j], gla_b2_bwd[j], gla_norm_g[j])
            op, (ka, va, sf, sb) = ab_mixer(hp, *prm, ctx=None)
            os_, _ = ab_mixer(hs, *prm, ctx=(cache_na_k[:, j], cache_na_v[:, j],
                                             state_gla_fwd[:, j], state_gla_bwd[:, j]))
            na_k.append(ka)
            na_v.append(va)
            gla_f.append(sf)
            gla_b.append(sb)
        else:
            prm = (gqa_w_in[j], gqa_w_out[j], gqa_q_norm_g[j], gqa_k_norm_g[j])
            op, (kc, vc) = c_mixer(hp, *prm, ctx=None)
            os_, _ = c_mixer(hs, *prm, ctx=(cache_gqa_k[:, j], cache_gqa_v[:, j]))
            gq_k.append(kc)
            gq_v.append(vc)
        xp = xp + g1p * op
        xs = xs + g1s * os_
        ffn = (ffn_w_up[i], ffn_conv_w[i], ffn_conv_b[i], ffn_w_down[i])
        xp = xp + g2p * conv_ffn(rms_norm(xp, norm_ffn_g[i]) * (1.0 + sc2p) + sh2p, *ffn)
        xs = xs + g2s * conv_ffn(rms_norm(xs, norm_ffn_g[i]) * (1.0 + sc2s) + sh2s, *ffn)
    y_prompt = rms_norm(xp, final_norm_g)
    y_sample = rms_norm(xs, final_norm_g)
    new_na_k = jnp.stack(na_k, axis=1)
    new_na_v = jnp.stack(na_v, axis=1)
    new_gla_fwd = jnp.stack(gla_f, axis=1)
    new_gla_bwd = jnp.stack(gla_b, axis=1)
    new_gqa_k = jnp.stack(gq_k, axis=1)
    new_gqa_v = jnp.stack(gq_v, axis=1)
    return (y_prompt, y_sample, new_na_k, new_na_v, new_gla_fwd, new_gla_bwd, new_gqa_k, new_gqa_v)
```

```cpp
#include <hip/hip_runtime.h>
#include <hip/hip_cooperative_groups.h>
#include <cstdio>
#include <cstdint>
namespace cg = cooperative_groups;

#define LAS __attribute__((address_space(3)))
typedef unsigned short bf16_t;
typedef short bf16x8 __attribute__((ext_vector_type(8)));
typedef short s16x4 __attribute__((ext_vector_type(4)));
typedef float f32x4 __attribute__((ext_vector_type(4)));
typedef unsigned u32x4 __attribute__((ext_vector_type(4)));
typedef unsigned u32x2 __attribute__((ext_vector_type(2)));

constexpr int DM = 1024, MP = 4096, MSAMP = 16384, MALL = 20480;
constexpr int AB_IN = 3104, AB_INP = 3328, QKVP_AB = 2080, QKVP_C = 1280, DFF = 2816;
constexpr float QSCALE = 0.125f * 1.4426950408889634f;
constexpr float LOG2E = 1.4426950408889634f;
constexpr float EPS = 1e-6f;
constexpr size_t OUT_NAK = 20971520, OUT_NAV = 25165824, OUT_GF = 29360128, OUT_GB = 30408704, OUT_GQK = 31457280, OUT_GQV = 33554432;
constexpr size_t MiB = 1u << 20;
constexpr size_t OFF_MOD = 1 * MiB, OFF_ROPE = 2 * MiB, OFF_GAM = 3 * MiB, OFF_CK_NA = 4 * MiB, OFF_CVT_NA = 8 * MiB, OFF_CK_GQ = 12 * MiB, OFF_CVT_GQ = 14 * MiB;
constexpr size_t OFF_WAB_IN = 16 * MiB, OFF_WAB_OUT = 29 * MiB, OFF_WC_IN = 33 * MiB, OFF_WC_OUT = 39 * MiB, OFF_WUP = 43 * MiB, OFF_WDN = 87 * MiB;
constexpr size_t OFF_H = 109 * MiB, OFF_QKV = 150 * MiB, OFF_VT = 232 * MiB, OFF_VTG = 252 * MiB, OFF_O = 272 * MiB, OFF_GST = 312 * MiB, WS_NEED = 352 * MiB;
constexpr int LDS_BYTES = 147456;

struct Params {
    const float *x_prompt, *x_sample, *cache_na_k, *cache_na_v, *st_f, *st_b, *cache_gqa_k, *cache_gqa_v, *c, *c_ctx,
        *ada_w, *ada_b, *norm_mix_g, *norm_ffn_g, *ab_w_in, *ab_w_out, *na_rpb, *w2f, *b2f, *w2b, *b2b, *gla_norm_g,
        *gqa_w_in, *gqa_w_out, *qn_g, *kn_g, *ffn_w_up, *conv_w, *conv_b, *ffn_w_down, *final_g;
    float* out; unsigned char* ws;
};

typedef float f32x2_t __attribute__((ext_vector_type(2)));
typedef __bf16 bf16x2_t __attribute__((ext_vector_type(2)));
__device__ __forceinline__ unsigned cvt_pk_bf16(float lo, float hi) { f32x2_t v = {lo, hi}; bf16x2_t b = __builtin_convertvector(v, bf16x2_t); return __builtin_bit_cast(unsigned, b); }
__device__ __forceinline__ float bf2f(unsigned short b) { return __builtin_bit_cast(float, (unsigned)b << 16); }
__device__ __forceinline__ float bflo(unsigned w) { return __builtin_bit_cast(float, w << 16); }
__device__ __forceinline__ float bfhi(unsigned w) { return __builtin_bit_cast(float, w & 0xffff0000u); }
__device__ __forceinline__ unsigned short f2bf1(float f) { return (unsigned short)(cvt_pk_bf16(f, 0.f) & 0xffffu); }
__device__ __forceinline__ float silu_f(float x) { return x * __builtin_amdgcn_rcpf(1.0f + __expf(-x)); }
__device__ __forceinline__ float wave_sum(float v) {
#pragma unroll
    for (int o = 1; o < 64; o <<= 1) v += __shfl_xor(v, o);
    return v;
}
__device__ __forceinline__ int opaque_tid() { int t = threadIdx.x; asm volatile("" : "+v"(t)); return t; }
__device__ __forceinline__ int cond_of_row(int m) { return m < MP ? 0 : 1 + ((m - MP) >> 11); }

namespace pg8 {
#define PG8_LAS __attribute__((address_space(3)))
constexpr int BM = 256, BK = 64, HALF = 128, HTB = HALF * BK * 2, STAGE_BYTES = 8 * HTB, NXCD = 8, WGM = 8;
__host__ __device__ __forceinline__ int lds_byte(int r, int c) { const int st = (r >> 4) * 2 + (c >> 5), rr = r & 15, cc = c & 31, ob = rr * 64 + cc * 2; return st * 1024 + (ob ^ (((ob >> 9) & 1) << 5)); }
__host__ __device__ __forceinline__ void stage_rc(int b, int& R, int& C) { const int st = b / 1024, sb = b % 1024, swz = sb ^ (((sb >> 9) & 1) << 5); R = (st >> 1) * 16 + swz / 64; C = (st & 1) * 32 + (swz % 64) / 2; }
__host__ __device__ __forceinline__ int perm32(int rho) { const int n = rho >> 4, i = rho & 15; return 8 * (i >> 2) + 4 * n + (i & 3); }
struct Unit { int pm, pn, k0, nk, part; };
struct Gemm { const bf16_t* A; const bf16_t* Bt; int M, N, K; };
struct StaticOrder {
    int nM, nN, nwg, G, c, ntK;
    __host__ __device__ __forceinline__ void init(int nM_, int nN_, int G_, int c_, int ntK_) { nM = nM_; nN = nN_; nwg = nM * nN; G = G_; c = c_; ntK = ntK_; }
    __host__ __device__ __forceinline__ void map(int L, Unit& u) const {
        int wgid = L; { const int q = nwg / NXCD, r = nwg % NXCD, xcd = wgid % NXCD, off = wgid / NXCD; wgid = (xcd < r ? xcd * (q + 1) : r * (q + 1) + (xcd - r) * q) + off; }
        const int nig = WGM * nN, gid = wgid / nig, fm = gid * WGM, gsz = (nM - fm) < WGM ? (nM - fm) : WGM;
        u.pm = fm + ((wgid % nig) % gsz); u.pn = (wgid % nig) / gsz; u.k0 = 0; u.nk = ntK; u.part = -1;
    }
    __host__ __device__ __forceinline__ bool next(int i, Unit& u) const {
        const long L = (long)i * G + c; if (L >= nwg) return false;
        map((int)L, u); return true;
    }
    __device__ __forceinline__ void a_ready(const Unit&) const {}
    __device__ __forceinline__ void done(const Unit&) const {}
};
struct TailSplitOrder {
    StaticOrder b;
    bool split;
    __device__ __forceinline__ bool next(int i, Unit& u) const {
        const bool r0 = (i == 0) || !split;
        const long L = (long)i * b.G + b.c;
        Unit a; b.map((int)(L < b.nwg ? L : 0), a);
        const int part = b.c & 3;
        const int q8 = b.ntK >> 2, q = q8 & ~1, extra = (b.ntK - 4 * q) >> 1;
        const bool eq = (b.ntK & 7) == 0;
        const int nk1 = eq ? q8 : q + (part < extra ? 2 : 0);
        const int k01 = eq ? part * q8 : part * q + 2 * (part < extra ? part : extra);
        u.pm = r0 ? a.pm : 64 + (b.c >> 4); u.pn = r0 ? a.pn : ((b.c >> 2) & 3);
        u.k0 = r0 ? 0 : k01; u.nk = r0 ? b.ntK : nk1; u.part = r0 ? -1 : part;
        return split ? (i <= 1) : (L < b.nwg);
    }
    __device__ __forceinline__ void a_ready(const Unit&) const {}
    __device__ __forceinline__ void done(const Unit&) const {}
};
template <class Epi, class Sched, bool ALIGN_EPI = false, bool SP2 = false, bool AREMAP = false>
__device__ __forceinline__ void gemm_phase(PG8_LAS unsigned char* lds, const Gemm g, const Sched& S, const Epi& E) {
    int tid_ = threadIdx.x; asm volatile("" : "+v"(tid_));
    const int tid = tid_, wid = __builtin_amdgcn_readfirstlane(tid >> 6), lane = tid & 63, wr = wid >> 2, wc = wid & 3, fr = lane & 15, fq = lane >> 4;
    const int K = g.K;
    unsigned voffA[2], voffB[2];
#pragma unroll
    for (int i = 0; i < 2; ++i) { int R, C; stage_rc(tid * 16 + i * 8192, R, C); const int Rb = Epi::PERM ? ((R & ~31) + perm32(R & 31)) : R;
        voffA[i] = (unsigned)(R * K + C) * 2u; voffB[i] = (unsigned)(Rb * K + C) * 2u; }
    const size_t kstep = (size_t)(BK * 2);
    const size_t hstep = (size_t)HALF * K * 2;
    const size_t tstep = 2 * hstep; const size_t hstepA = hstep; const size_t tstepA = AREMAP ? (size_t)254 * K * 2 : tstep;
    const unsigned ldsw = (unsigned)wid * 1024u;
    const int aoff = lds_byte(wr * 64 + fr, fq * 8), boff = lds_byte(wc * 32 + fr, fq * 8);
#define PG8_SA(b, h) (((b) * 2 + (h)) * HTB)
#define PG8_SB(b, h) ((4 + (b) * 2 + (h)) * HTB)
#define PG8_STAGE(bufoff, gbase, voff) do { _Pragma("unroll") for (int _i = 0; _i < 2; ++_i) \
        __builtin_amdgcn_global_load_lds((const unsigned*)((const char*)(gbase) + (voff)[_i]), (PG8_LAS unsigned*)(lds + (bufoff) + ldsw + _i * 8192), 16, 0, 0); } while (0)
#define PG8_LDA(dst, b, h) do { _Pragma("unroll") for (int m = 0; m < 4; ++m) _Pragma("unroll") for (int k = 0; k < 2; ++k) dst[m][k] = *(const PG8_LAS bf16x8*)(lds + PG8_SA(b, h) + aoff + m * 2048 + k * 1024); } while (0)
#define PG8_LDB(dst, b, h) do { _Pragma("unroll") for (int n = 0; n < 2; ++n) _Pragma("unroll") for (int k = 0; k < 2; ++k) dst[n][k] = *(const PG8_LAS bf16x8*)(lds + PG8_SB(b, h) + boff + n * 2048 + k * 1024); } while (0)
#define PG8_MMA(ai, bj, At, Bt) do { __builtin_amdgcn_s_setprio(1); _Pragma("unroll") for (int m = 0; m < 4; ++m) _Pragma("unroll") for (int n = 0; n < 2; ++n) _Pragma("unroll") for (int k = 0; k < 2; ++k) \
        acc[ai][bj][m][n] = __builtin_amdgcn_mfma_f32_16x16x32_bf16(Bt[n][k], At[m][k], acc[ai][bj][m][n], 0, 0, 0); __builtin_amdgcn_s_setprio(0); } while (0)
#define PG8_WAIT_V(n) asm volatile("s_waitcnt vmcnt(" #n ")" ::: "memory")
#define PG8_WAIT_L(n) asm volatile("s_waitcnt lgkmcnt(" #n ")" ::: "memory")
#define PG8_BAR __builtin_amdgcn_s_barrier()
#define PG8_SCHED __builtin_amdgcn_sched_barrier(0)
    Unit cur, nxt; int ui = 0;
    if (!S.next(0, cur)) return;
    f32x4 acc[2][2][4][2];
#pragma unroll
    for (int a = 0; a < 2; ++a)
#pragma unroll
        for (int b = 0; b < 2; ++b)
#pragma unroll
            for (int m = 0; m < 4; ++m)
#pragma unroll
                for (int n = 0; n < 2; ++n) acc[a][b][m][n] = (f32x4){0.f, 0.f, 0.f, 0.f};
    bf16x8 At[4][2], B0[2][2], B1[2][2];
    const char* cA = (const char*)g.A + (size_t)cur.pm * tstepA + (size_t)cur.k0 * (BK * 2); const char* cB = (const char*)g.Bt + (size_t)cur.pn * tstep + (size_t)cur.k0 * (BK * 2);
    S.a_ready(cur);
    if constexpr (SP2) {
        PG8_STAGE(PG8_SB(0, 0), cB, voffB); PG8_STAGE(PG8_SB(0, 1), cB + hstep, voffB); PG8_STAGE(PG8_SA(0, 0), cA, voffA); PG8_STAGE(PG8_SA(0, 1), cA + hstepA, voffA);
        if (wr == 1) PG8_BAR;
        PG8_WAIT_V(2); PG8_BAR;
        PG8_STAGE(PG8_SB(1, 0), cB + kstep, voffB); PG8_STAGE(PG8_SA(1, 0), cA + kstep, voffA); PG8_STAGE(PG8_SB(1, 1), cB + hstep + kstep, voffB);
        PG8_WAIT_V(6); PG8_BAR;
    } else {
        PG8_STAGE(PG8_SB(0, 0), cB, voffB); PG8_STAGE(PG8_SA(0, 0), cA, voffA); PG8_STAGE(PG8_SB(0, 1), cB + hstep, voffB); PG8_STAGE(PG8_SA(0, 1), cA + hstepA, voffA);
        if (wr == 1) PG8_BAR;
        PG8_WAIT_V(4); PG8_BAR;
        PG8_STAGE(PG8_SB(1, 0), cB + kstep, voffB); PG8_STAGE(PG8_SA(1, 0), cA + kstep, voffA); PG8_STAGE(PG8_SB(1, 1), cB + hstep + kstep, voffB);
        PG8_WAIT_V(6); PG8_BAR;
    }
    for (;;) {
        const bool has_next = S.next(ui + 1, nxt);
        const char* nA = has_next ? (const char*)g.A + (size_t)nxt.pm * tstepA + (size_t)nxt.k0 * (BK * 2) : cA; const char* nB = has_next ? (const char*)g.Bt + (size_t)nxt.pn * tstep + (size_t)nxt.k0 * (BK * 2) : cB;
        const int nt = cur.nk;
        for (int t = 0; t < nt; t += 2) {
            const bool last = (t == nt - 2);
            const char* a1 = cA + (size_t)(t + 1) * kstep;
            const char* a2 = last ? nA : cA + (size_t)(t + 2) * kstep; const char* b2 = last ? nB : cB + (size_t)(t + 2) * kstep;
            const char* a3 = a2 + kstep; const char* b3 = b2 + kstep;
            if (last && has_next) S.a_ready(nxt);
            if constexpr (SP2) {
            PG8_LDB(B0, 0, 0); PG8_LDB(B1, 0, 1); PG8_SCHED; PG8_LDA(At, 0, 0); PG8_STAGE(PG8_SA(1, 1), a1 + hstepA, voffA);
            PG8_WAIT_V(8); PG8_WAIT_L(0); PG8_BAR; PG8_MMA(0, 0, At, B0); PG8_MMA(0, 1, At, B1); PG8_BAR; PG8_SCHED;
            PG8_LDA(At, 0, 1); PG8_STAGE(PG8_SB(0, 0), b2, voffB); PG8_STAGE(PG8_SB(0, 1), b2 + hstep, voffB); PG8_STAGE(PG8_SA(0, 0), a2, voffA);
            PG8_WAIT_V(8); PG8_WAIT_L(0); PG8_BAR; PG8_MMA(1, 0, At, B0); PG8_MMA(1, 1, At, B1); PG8_BAR; PG8_SCHED;
            PG8_LDB(B0, 1, 0); PG8_LDB(B1, 1, 1); PG8_SCHED; PG8_LDA(At, 1, 0); PG8_STAGE(PG8_SA(0, 1), a2 + hstepA, voffA);
            PG8_WAIT_V(8); PG8_WAIT_L(0); PG8_BAR; PG8_MMA(0, 0, At, B0); PG8_MMA(0, 1, At, B1); PG8_BAR; PG8_SCHED;
            PG8_LDA(At, 1, 1); PG8_STAGE(PG8_SB(1, 0), b3, voffB); PG8_STAGE(PG8_SB(1, 1), b3 + hstep, voffB); PG8_STAGE(PG8_SA(1, 0), a3, voffA);
            PG8_WAIT_V(8); PG8_WAIT_L(0); PG8_BAR; PG8_MMA(1, 0, At, B0); PG8_MMA(1, 1, At, B1); PG8_BAR; PG8_SCHED;
            } else {
            PG8_LDB(B0, 0, 0); PG8_SCHED; PG8_LDA(At, 0, 0); PG8_STAGE(PG8_SA(1, 1), a1 + hstepA, voffA);
            PG8_WAIT_L(8); PG8_BAR; PG8_WAIT_L(0); PG8_MMA(0, 0, At, B0); PG8_BAR; PG8_SCHED;
            PG8_LDB(B1, 0, 1); PG8_STAGE(PG8_SB(0, 0), b2, voffB);
            PG8_BAR; PG8_WAIT_L(0); PG8_MMA(0, 1, At, B1); PG8_BAR;
            PG8_LDA(At, 0, 1); PG8_STAGE(PG8_SA(0, 0), a2, voffA);
            PG8_BAR; PG8_WAIT_L(0); PG8_MMA(1, 0, At, B0); PG8_BAR; PG8_SCHED;
            PG8_STAGE(PG8_SB(0, 1), b2 + hstep, voffB);
            PG8_WAIT_V(6); PG8_BAR; PG8_MMA(1, 1, At, B1); PG8_BAR;
            PG8_LDB(B0, 1, 0); PG8_SCHED; PG8_LDA(At, 1, 0); PG8_STAGE(PG8_SA(0, 1), a2 + hstepA, voffA);
            PG8_WAIT_L(8); PG8_BAR; PG8_WAIT_L(0); PG8_MMA(0, 0, At, B0); PG8_BAR; PG8_SCHED;
            PG8_LDB(B1, 1, 1); PG8_STAGE(PG8_SB(1, 0), b3, voffB);
            PG8_BAR; PG8_WAIT_L(0); PG8_MMA(0, 1, At, B1); PG8_BAR;
            PG8_LDA(At, 1, 1); PG8_STAGE(PG8_SA(1, 0), a3, voffA);
            PG8_BAR; PG8_WAIT_L(0); PG8_MMA(1, 0, At, B0); PG8_BAR; PG8_SCHED;
            PG8_STAGE(PG8_SB(1, 1), b3 + hstep, voffB);
            PG8_WAIT_V(6); PG8_BAR; PG8_MMA(1, 1, At, B1); PG8_BAR;
            }
        }
        if constexpr (ALIGN_EPI) { if (wr == 0) PG8_BAR; }
        if constexpr (!Epi::AFTER_DRAIN) { E(acc, cur, wr, wc, fr, fq); S.done(cur); }
        if (!has_next) break;
#pragma unroll
        for (int a = 0; a < 2; ++a)
#pragma unroll
            for (int b = 0; b < 2; ++b)
#pragma unroll
                for (int m = 0; m < 4; ++m)
#pragma unroll
                    for (int n = 0; n < 2; ++n) acc[a][b][m][n] = (f32x4){0.f, 0.f, 0.f, 0.f};
        cur = nxt; cA = nA; cB = nB; ++ui;
        if constexpr (ALIGN_EPI) { if (wr == 1) PG8_BAR; }
    }
    PG8_WAIT_V(0);
    if constexpr (!ALIGN_EPI) { if (wr == 0) PG8_BAR; }
    PG8_BAR;
    if constexpr (Epi::AFTER_DRAIN) { E.fused(acc, cur, wr, wc, fr, fq, lds, wid, lane); S.done(cur); }
#undef PG8_SA
#undef PG8_SB
#undef PG8_STAGE
#undef PG8_LDA
#undef PG8_LDB
#undef PG8_MMA
#undef PG8_WAIT_V
#undef PG8_WAIT_L
#undef PG8_BAR
#undef PG8_SCHED
}
}

using pg8::Unit;
__device__ __forceinline__ void st_bf16x8(bf16_t* p, const f32x4& v0, const f32x4& v1) {
    u32x4 w; w.x = cvt_pk_bf16(v0[0], v0[1]); w.y = cvt_pk_bf16(v0[2], v0[3]); w.z = cvt_pk_bf16(v1[0], v1[1]); w.w = cvt_pk_bf16(v1[2], v1[3]);
    *(u32x4*)p = w;
}

struct EpiABIn {
    static constexpr bool PERM = true, AFTER_DRAIN = false;
    bf16_t* qkv; bf16_t* vt; bf16_t* vtg; float* out_k; float* out_v; int jl;
    __device__ __forceinline__ void operator()(f32x4 (&acc)[2][2][4][2], const Unit& u, int wr, int wc, int fr, int fq) const {
#pragma unroll
        for (int bj = 0; bj < 2; ++bj) {
            const int cbase = u.pn * 256 + bj * 128 + wc * 32;
            if (cbase >= AB_IN) continue;
            const int c0 = cbase + 8 * fq;
#pragma unroll
            for (int ai = 0; ai < 2; ++ai)
#pragma unroll
                for (int m = 0; m < 4; ++m) {
                    const int r = u.pm * 256 + ai * 128 + wr * 64 + m * 16 + fr;
                    f32x4 v0 = acc[ai][bj][m][0], v1 = acc[ai][bj][m][1];
                    if (cbase < 512) { v0 = v0 * QSCALE; v1 = v1 * QSCALE; st_bf16x8(qkv + (size_t)r * QKVP_AB + c0, v0, v1); }
                    else if (cbase < 1024) {
                        st_bf16x8(qkv + (size_t)r * QKVP_AB + c0, v0, v1);
                        if (r < MP) { const int cc = c0 - 512; float* o = out_k + ((((size_t)(r >> 8) * 2 + jl) * 8 + (cc >> 6)) * 256 + (r & 255)) * 64 + (cc & 63); *(f32x4*)o = v0; *(f32x4*)(o + 4) = v1; }
                    } else if (cbase < 1536) {
                        const int cc = c0 - 1024, hh = cc >> 6, d = cc & 63;
                        bf16_t* dst; int T;
                        if (r < MP) { T = 256; dst = vt + ((size_t)((r >> 8) * 8 + hh) * 64 + d) * 256 + (r & 255);
                            float* o = out_v + ((((size_t)(r >> 8) * 2 + jl) * 8 + hh) * 256 + (r & 255)) * 64 + d; *(f32x4*)o = v0; *(f32x4*)(o + 4) = v1; }
                        else { const int rs = r - MP; T = 2048; dst = vt + (size_t)MP * 512 + ((size_t)((rs >> 11) * 8 + hh) * 64 + d) * 2048 + (rs & 2047); }
#pragma unroll
                        for (int i = 0; i < 4; ++i) { dst[(size_t)i * T] = f2bf1(v0[i]); dst[(size_t)(i + 4) * T] = f2bf1(v1[i]); }
                    } else if (cbase < 2048) { st_bf16x8(qkv + (size_t)r * QKVP_AB + c0 - 512, v0, v1); }
                    else if (cbase < 2560) {
                        const int cc = c0 - 2048, hh = cc >> 7, e = cc & 127;
                        bf16_t* dst; int T;
                        if (r < MP) { T = 256; dst = vtg + ((size_t)((r >> 8) * 4 + hh) * 128 + e) * 256 + (r & 255); }
                        else { const int rs = r - MP; T = 2048; dst = vtg + (size_t)MP * 512 + ((size_t)((rs >> 11) * 4 + hh) * 128 + e) * 2048 + (rs & 2047); }
#pragma unroll
                        for (int i = 0; i < 4; ++i) { dst[(size_t)i * T] = f2bf1(v0[i]); dst[(size_t)(i + 4) * T] = f2bf1(v1[i]); }
                    } else { st_bf16x8(qkv + (size_t)r * QKVP_AB + c0 - 1024, v0, v1); }
                }
        }
    }
};

struct EpiCIn {
    static constexpr bool PERM = true, AFTER_DRAIN = false;
    bf16_t* qkv; bf16_t* vt; float* out_k; float* out_v; const float* qn; const float* kn; const float* ropec; const float* ropes; int jl;
    __device__ __forceinline__ void operator()(f32x4 (&acc)[2][2][4][2], const Unit& u, int wr, int wc, int fr, int fq) const {
        const int pn = u.pn;
        const bool sample = u.pm >= 16;
        if (pn < 5) {
            const float* gw = pn < 4 ? qn : kn;
            f32x4 g[2][2];
#pragma unroll
            for (int bj = 0; bj < 2; ++bj)
#pragma unroll
                for (int n = 0; n < 2; ++n) g[bj][n] = *(const f32x4*)(gw + 32 * bj + 8 * fq + 4 * n);
#pragma unroll
            for (int ai = 0; ai < 2; ++ai)
#pragma unroll
                for (int m = 0; m < 4; ++m) {
                    const int r = u.pm * 256 + ai * 128 + wr * 64 + m * 16 + fr;
                    float ss = 0.f;
#pragma unroll
                    for (int bj = 0; bj < 2; ++bj)
#pragma unroll
                        for (int n = 0; n < 2; ++n) { const f32x4 x = acc[ai][bj][m][n]; ss += (x[0] * x[0] + x[1] * x[1]) + (x[2] * x[2] + x[3] * x[3]); }
                    ss += __shfl_xor(ss, 16); ss += __shfl_xor(ss, 32);
                    const float rstd = rsqrtf(ss * (1.0f / 64.0f) + EPS);
                    f32x4 v[2][2];
#pragma unroll
                    for (int bj = 0; bj < 2; ++bj)
#pragma unroll
                        for (int n = 0; n < 2; ++n) v[bj][n] = acc[ai][bj][m][n] * rstd * g[bj][n];
                    if (pn == 4 && !sample) {
#pragma unroll
                        for (int bj = 0; bj < 2; ++bj) { float* o = out_k + ((((size_t)(r >> 8) * 2 + jl) * 4 + wc) * 256 + (r & 255)) * 64 + 32 * bj + 8 * fq; *(f32x4*)o = v[bj][0]; *(f32x4*)(o + 4) = v[bj][1]; }
                    }
                    if (sample) {
                        const int t = (r - MP) & 2047;
#pragma unroll
                        for (int bj = 0; bj < 2; ++bj)
#pragma unroll
                            for (int n = 0; n < 2; ++n) {
                                const int f = 16 * bj + 8 * (fq & 1) + 4 * n;
                                const f32x4 cs = *(const f32x4*)(ropec + t * 32 + f), sn = *(const f32x4*)(ropes + t * 32 + f);
                                f32x4 pv;
#pragma unroll
                                for (int j = 0; j < 4; ++j) pv[j] = __shfl_xor(v[bj][n][j], 32);
                                if (fq < 2) v[bj][n] = v[bj][n] * cs - pv * sn; else v[bj][n] = v[bj][n] * cs + pv * sn;
                            }
                    }
                    if (pn < 4) {
#pragma unroll
                        for (int bj = 0; bj < 2; ++bj) st_bf16x8(qkv + (size_t)r * QKVP_C + (4 * pn + wc) * 64 + 32 * bj + 8 * fq, v[bj][0] * QSCALE, v[bj][1] * QSCALE);
                    } else {
#pragma unroll
                        for (int bj = 0; bj < 2; ++bj) st_bf16x8(qkv + (size_t)r * QKVP_C + 1024 + wc * 64 + 32 * bj + 8 * fq, v[bj][0], v[bj][1]);
                    }
                }
        } else {
#pragma unroll
            for (int ai = 0; ai < 2; ++ai)
#pragma unroll
                for (int m = 0; m < 4; ++m) {
                    const int r = u.pm * 256 + ai * 128 + wr * 64 + m * 16 + fr;
#pragma unroll
                    for (int bj = 0; bj < 2; ++bj) {
                        const int d = 32 * bj + 8 * fq;
                        const f32x4 v0 = acc[ai][bj][m][0], v1 = acc[ai][bj][m][1];
                        bf16_t* dst; int T;
                        if (!sample) { T = 256; dst = vt + ((size_t)((r >> 8) * 4 + wc) * 64 + d) * 256 + (r & 255);
                            float* o = out_v + ((((size_t)(r >> 8) * 2 + jl) * 4 + wc) * 256 + (r & 255)) * 64 + d; *(f32x4*)o = v0; *(f32x4*)(o + 4) = v1; }
                        else { const int rs = r - MP; T = 2048; dst = vt + (size_t)MP * 256 + ((size_t)((rs >> 11) * 4 + wc) * 64 + d) * 2048 + (rs & 2047); }
#pragma unroll
                        for (int i = 0; i < 4; ++i) { dst[(size_t)i * T] = f2bf1(v0[i]); dst[(size_t)(i + 4) * T] = f2bf1(v1[i]); }
                    }
                }
        }
    }
};

struct EpiRes {
    static constexpr bool PERM = true, AFTER_DRAIN = false;
    float* x; const float* gate; bf16_t* pend;
    __device__ __forceinline__ void operator()(f32x4 (&acc)[2][2][4][2], const Unit& u, int wr, int wc, int fr, int fq) const {
#pragma unroll
        for (int ai = 0; ai < 2; ++ai)
#pragma unroll
            for (int m = 0; m < 4; ++m) {
                const int r = u.pm * 256 + ai * 128 + wr * 64 + m * 16 + fr;
                const float* gp = gate + (size_t)cond_of_row(r) * 6144;
#pragma unroll
                for (int bj = 0; bj < 2; ++bj) {
                    const int c0 = u.pn * 256 + bj * 128 + wc * 32 + 8 * fq;
                    float* xp = x + (size_t)r * DM + c0;
                    const f32x4 g0 = *(const f32x4*)(gp + c0), g1 = *(const f32x4*)(gp + c0 + 4);
                    if (u.part < 0) {
                        f32x4 x0 = *(f32x4*)xp, x1 = *(f32x4*)(xp + 4);
                        x0 = x0 + g0 * acc[ai][bj][m][0]; x1 = x1 + g1 * acc[ai][bj][m][1];
                        *(f32x4*)xp = x0; *(f32x4*)(xp + 4) = x1;
                    } else {
                        st_bf16x8(pend + ((size_t)u.part * 4096 + (r - 16384)) * DM + c0, g0 * acc[ai][bj][m][0], g1 * acc[ai][bj][m][1]);
                    }
                    __builtin_amdgcn_sched_barrier(0);
                }
            }
    }
};

struct OneUnit {
    Unit u;
    __device__ __forceinline__ bool next(int i, Unit& o) const { if (i) return false; o = u; return true; }
    __device__ __forceinline__ void a_ready(const Unit&) const {}
    __device__ __forceinline__ void done(const Unit&) const {}
};
constexpr int UP_PITCH = 528;
struct EpiUp {
    static constexpr bool PERM = true, AFTER_DRAIN = true;
    bf16_t* act; const float* cw; const float* cb;
    __device__ __forceinline__ void fused(f32x4 (&acc)[2][2][4][2], const Unit& u, int wr, int wc, int fr, int fq, LAS unsigned char* lds, int wid, int lane) const {
#pragma unroll
        for (int ai = 0; ai < 2; ++ai)
#pragma unroll
            for (int m = 0; m < 4; ++m)
#pragma unroll
                for (int bj = 0; bj < 2; ++bj) {
                    const f32x4 v0 = acc[ai][bj][m][0], v1 = acc[ai][bj][m][1];
                    u32x4 w; w.x = cvt_pk_bf16(v0[0], v0[1]); w.y = cvt_pk_bf16(v0[2], v0[3]); w.z = cvt_pk_bf16(v1[0], v1[1]); w.w = cvt_pk_bf16(v1[2], v1[3]);
                    *(LAS u32x4*)(lds + ((2 * ai + wr) * 64 + 16 * m + fr) * UP_PITCH + (bj * 128 + wc * 32 + 8 * fq) * 2) = w;
                }
        if (wid == 0 && lane < 33) *(LAS u32x4*)(lds + 256 * UP_PITCH + lane * 16) = (u32x4){0u, 0u, 0u, 0u};
        __syncthreads();
        const int tid = wid * 64 + lane, chunk = tid & 15;
        const int cval = u.pn * 128 + chunk * 8;
        f32x4 wv[3][2], wg[3][2], bv[2], bg[2];
#pragma unroll
        for (int h = 0; h < 2; ++h) {
#pragma unroll
            for (int t = 0; t < 3; ++t) { wv[t][h] = *(const f32x4*)(cw + t * 2 * DFF + cval + 4 * h); wg[t][h] = *(const f32x4*)(cw + t * 2 * DFF + DFF + cval + 4 * h); }
            bv[h] = *(const f32x4*)(cb + cval + 4 * h); bg[h] = *(const f32x4*)(cb + DFF + cval + 4 * h);
        }
        for (int i = 0; i < 8; ++i) {
            const int row = (tid >> 4) + 32 * i;
            const int R = u.pm * 254 - 1 + row;
            if (row < 1 || row > 254 || R < 0 || R >= MALL) continue;
            int t, T; if (R < MP) { t = R & 255; T = 256; } else { t = (R - MP) & 2047; T = 2048; }
            const bool hl = t > 0, hr = t < T - 1;
            const LAS unsigned char* rp = lds + row * UP_PITCH + chunk * 16;
            const LAS unsigned char* zrow = lds + 256 * UP_PITCH;
            const LAS unsigned char* rpp = hl ? rp - UP_PITCH : zrow + chunk * 16;
            const LAS unsigned char* rpn = hr ? rp + UP_PITCH : zrow + chunk * 16;
            const u32x4 pv = *(const LAS u32x4*)rpp, cv = *(const LAS u32x4*)rp, nv = *(const LAS u32x4*)rpn;
            const u32x4 pg = *(const LAS u32x4*)(rpp + 256), cg_ = *(const LAS u32x4*)(rp + 256), ng = *(const LAS u32x4*)(rpn + 256);
            float o[8];
#pragma unroll
            for (int e = 0; e < 8; ++e) {
                const int h = e >> 2, j = e & 3;
                const unsigned wp = e < 2 ? pv.x : e < 4 ? pv.y : e < 6 ? pv.z : pv.w, wc_ = e < 2 ? cv.x : e < 4 ? cv.y : e < 6 ? cv.z : cv.w, wn = e < 2 ? nv.x : e < 4 ? nv.y : e < 6 ? nv.z : nv.w;
                const unsigned gp = e < 2 ? pg.x : e < 4 ? pg.y : e < 6 ? pg.z : pg.w, gc = e < 2 ? cg_.x : e < 4 ? cg_.y : e < 6 ? cg_.z : cg_.w, gn = e < 2 ? ng.x : e < 4 ? ng.y : e < 6 ? ng.z : ng.w;
                const float vp = (e & 1) ? bfhi(wp) : bflo(wp), vc = (e & 1) ? bfhi(wc_) : bflo(wc_), vn = (e & 1) ? bfhi(wn) : bflo(wn);
                const float qp = (e & 1) ? bfhi(gp) : bflo(gp), qc = (e & 1) ? bfhi(gc) : bflo(gc), qn = (e & 1) ? bfhi(gn) : bflo(gn);
                const float val = wv[0][h][j] * vp + wv[1][h][j] * vc + wv[2][h][j] * vn + bv[h][j];
                const float gat = wg[0][h][j] * qp + wg[1][h][j] * qc + wg[2][h][j] * qn + bg[h][j];
                o[e] = silu_f(gat) * val;
            }
            u32x4 w; w.x = cvt_pk_bf16(o[0], o[1]); w.y = cvt_pk_bf16(o[2], o[3]); w.z = cvt_pk_bf16(o[4], o[5]); w.w = cvt_pk_bf16(o[6], o[7]);
            *(u32x4*)(act + (size_t)R * DFF + cval) = w;
        }
        __syncthreads();
    }
};

#define MFMA16(a, b, c) __builtin_amdgcn_mfma_f32_16x16x32_bf16((a), (b), (c), 0, 0, 0)
constexpr int AT_KB = 0, AT_VB = 36864, AT_BIAS = 73728;

#define MASKED_SKIP(g) false
template <bool MASKED, class TileFn, class RowFn, class ActiveFn>
__device__ __forceinline__ void flash_unit(LAS unsigned char* lds, int nkt, TileFn tile, RowFn keyrow, ActiveFn active, bool wave_on,
                                           const bf16_t* q0, size_t qstride16, bf16_t* o0, size_t ostride16, int qrow) {
    const int tid = opaque_tid(), lane = tid & 63, fr = lane & 15, fq = lane >> 4;
    bf16x8 qf[4][2];
#pragma unroll
    for (int g = 0; g < 4; ++g) { qf[g][0] = *(const bf16x8*)(q0 + g * qstride16 + fq * 8); qf[g][1] = *(const bf16x8*)(q0 + g * qstride16 + 32 + fq * 8); }
    f32x4 o[4][4], lacc[4];
    f32x4 negm[4];
    bool fresh = true;
    bf16x8 ones;
#pragma unroll
    for (int i = 0; i < 8; ++i) ones[i] = (short)0x3F80;
#pragma unroll
    for (int g = 0; g < 4; ++g) { negm[g] = (f32x4){0.f, 0.f, 0.f, 0.f}; lacc[g] = (f32x4){0.f, 0.f, 0.f, 0.f};
#pragma unroll
        for (int a = 0; a < 4; ++a) o[a][g] = (f32x4){0.f, 0.f, 0.f, 0.f}; }
    const int srow = tid >> 3, sc = tid & 7;
    u32x4 kreg[1], vreg[1];
    auto gload = [&](int kt, int r) { const bf16_t* kp; const bf16_t* vp; int kpi, vpi; tile(kt, kp, kpi, vp, vpi);
        kreg[r] = *(const u32x4*)(kp + (size_t)srow * kpi + sc * 8); vreg[r] = *(const u32x4*)(vp + (size_t)srow * vpi + sc * 8); };
    auto sstore = [&](int kt, int r) { *(LAS u32x4*)(lds + AT_KB + (kt & 3) * 9216 + srow * 144 + sc * 16) = kreg[r]; *(LAS u32x4*)(lds + AT_VB + (kt & 3) * 9216 + srow * 144 + sc * 16) = vreg[r]; };
    gload(0, 0); sstore(0, 0);
    if (nkt > 1) { gload(1, 0); sstore(1, 0); }
    __syncthreads();
    const LAS float* bias = (const LAS float*)(lds + AT_BIAS);
    unsigned dcp[2][2][4];
    if (MASKED) {
#pragma unroll
        for (int hk = 0; hk < 2; ++hk)
#pragma unroll
            for (int tl = 0; tl < 2; ++tl)
#pragma unroll
                for (int g = 0; g < 4; ++g) {
                    const int qc = 16 * g + fr, cs = min(max(qc - 8, 0), 48);
                    unsigned pk = 0;
#pragma unroll
                    for (int j = 0; j < 4; ++j) {
                        const int kc = 32 * hk + 16 * tl + 4 * fq + j;
                        const bool ok = (kc >= cs) && (kc < cs + 16);
                        const int dc = ok ? min(max(kc - qc + 15, 0), 30) : 31;
                        pk |= (unsigned)(dc * 4) << (8 * j);
                    }
                    dcp[hk][tl][g] = pk;
                }
    }
    auto tile_compute = [&](int kt) {
        if (wave_on && active(kt)) {
            const int buf = kt & 3;
            const LAS unsigned char* Kb = lds + AT_KB + buf * 9216; const LAS unsigned char* Vb = lds + AT_VB + buf * 9216;
            const int kr = MASKED ? keyrow(kt) : -1;
            auto qk = [&](int hk, f32x4 (&sd)[2][4]) {
#pragma unroll
                for (int tl = 0; tl < 2; ++tl) {
                    const bf16x8 kf0 = *(const LAS bf16x8*)(Kb + ((2 * hk + tl) * 16 + fr) * 144 + fq * 16);
                    const bf16x8 kf1 = *(const LAS bf16x8*)(Kb + ((2 * hk + tl) * 16 + fr) * 144 + 64 + fq * 16);
#pragma unroll
                    for (int g = 0; g < 4; ++g) sd[tl][g] = MFMA16(kf0, qf[g][0], negm[g]);
#pragma unroll
                    for (int g = 0; g < 4; ++g) sd[tl][g] = MFMA16(kf1, qf[g][1], sd[tl][g]);
                }
            };
            auto half_body = [&](int hk, f32x4 (&s)[2][4], f32x4 (*other)[4]) {
                if (MASKED) {
                    if (kr >= 0) {
                        const LAS unsigned char* brow = (const LAS unsigned char*)(bias + (kr - qrow + 7) * 32);
#pragma unroll
                        for (int g = 0; g < 4; ++g)
#pragma unroll
                            for (int tl = 0; tl < 2; ++tl) {
                                const unsigned pk = hk ? dcp[1][tl][g] : dcp[0][tl][g];
#pragma unroll
                                for (int j = 0; j < 4; ++j) s[tl][g][j] += *(const LAS float*)(brow + ((pk >> (8 * j)) & 0xffu));
                            }
                    }
                }
                bool need = fresh;
#pragma unroll
                for (int g = 0; g < 4; ++g) {
                    if (MASKED_SKIP(g)) continue;
                    typedef int i32x4 __attribute__((ext_vector_type(4)));
                    const i32x4 a = __builtin_bit_cast(i32x4, s[0][g]), b = __builtin_bit_cast(i32x4, s[1][g]);
                    const int m1 = max(max(a[0], a[1]), a[2]), m2 = max(max(a[3], b[0]), b[1]), m3 = max(max(b[2], b[3]), m1);
                    need = need || (max(m2, m3) > 0x41000000);
                }
                if (__any(need)) {
#pragma unroll
                    for (int g = 0; g < 4; ++g) {
                        if (MASKED_SKIP(g)) continue;
                        const f32x4 m4 = __builtin_elementwise_max(s[0][g], s[1][g]);
                        float r = fmaxf(fmaxf(m4[0], m4[1]), fmaxf(m4[2], m4[3])); r = fmaxf(r, __shfl_xor(r, 16)); r = fmaxf(r, __shfl_xor(r, 32));
                        const float rr = fresh ? r : fmaxf(r, 0.0f);
                        const float alpha = fresh ? 0.0f : __builtin_amdgcn_exp2f(-rr);
                        negm[g] = negm[g] - rr; lacc[g] = lacc[g] * alpha;
                        s[0][g] = s[0][g] - rr; s[1][g] = s[1][g] - rr;
                        if (other) { other[0][g] = other[0][g] - rr; other[1][g] = other[1][g] - rr; }
#pragma unroll
                        for (int a = 0; a < 4; ++a) o[a][g] = o[a][g] * alpha;
                    }
                }
                fresh = false;
                bf16x8 pf[4];
#pragma unroll
                for (int g = 0; g < 4; ++g) {
#pragma unroll
                    for (int tl = 0; tl < 2; ++tl) {
                        f32x4 e = s[tl][g];
                        e[0] = __builtin_amdgcn_exp2f(e[0]); e[1] = __builtin_amdgcn_exp2f(e[1]); e[2] = __builtin_amdgcn_exp2f(e[2]); e[3] = __builtin_amdgcn_exp2f(e[3]);
                        s[tl][g] = e;
                    }
                    u32x4 w; w.x = cvt_pk_bf16(s[0][g][0], s[0][g][1]); w.y = cvt_pk_bf16(s[0][g][2], s[0][g][3]);
                    w.z = cvt_pk_bf16(s[1][g][0], s[1][g][1]); w.w = cvt_pk_bf16(s[1][g][2], s[1][g][3]);
                    pf[g] = __builtin_bit_cast(bf16x8, w);
                    lacc[g] = MFMA16(ones, pf[g], lacc[g]);
                }
#pragma unroll
                for (int dt = 0; dt < 4; ++dt) {
                    const LAS unsigned char* vp = Vb + (dt * 16 + fr) * 144 + hk * 64 + fq * 8;
                    const u32x2 lo = *(const LAS u32x2*)vp, hi = *(const LAS u32x2*)(vp + 32);
                    u32x4 w; w.x = lo.x; w.y = lo.y; w.z = hi.x; w.w = hi.y;
                    const bf16x8 vf = __builtin_bit_cast(bf16x8, w);
#pragma unroll
                    for (int g = 0; g < 4; ++g) o[dt][g] = MFMA16(vf, pf[g], o[dt][g]);
                }
            };
            if constexpr (MASKED) {
#pragma unroll 1
                for (int hk = 0; hk < 2; ++hk) { f32x4 s1[2][4]; qk(hk, s1); half_body(hk, s1, nullptr); }
            } else {
                f32x4 sb[2][2][4];
                qk(0, sb[0]); qk(1, sb[1]);
                __builtin_amdgcn_sched_barrier(0);
                half_body(0, sb[0], sb[1]);
                __builtin_amdgcn_sched_barrier(0);
                half_body(1, sb[1], nullptr);
                __builtin_amdgcn_sched_barrier(0);
            }
        }
    };
    for (int kt = 0; kt < nkt; ++kt) {
        if (kt + 2 < nkt) gload(kt + 2, 0);
        tile_compute(kt);
        if (kt + 2 < nkt) sstore(kt + 2, 0);
        if (kt & 1) __syncthreads();
    }
    if (nkt & 1) __syncthreads();
    if (wave_on) {
#pragma unroll
        for (int g = 0; g < 4; ++g) {
            const float inv = 1.0f / lacc[g][0];
            bf16_t* op = o0 + g * ostride16;
#pragma unroll
            for (int dt = 0; dt < 4; ++dt) {
                u32x2 w; w.x = cvt_pk_bf16(o[dt][g][0] * inv, o[dt][g][1] * inv); w.y = cvt_pk_bf16(o[dt][g][2] * inv, o[dt][g][3] * inv);
                *(u32x2*)(op + dt * 16 + 4 * fq) = w;
            }
        }
    }
}

constexpr int GL_QF = 0, GL_QB = 9216, GL_KF = 18432, GL_KB = 27648, GL_VT = 36864, GL_SF = 55296, GL_SB = 73728, GL_OB = 92160, GL_GT = 125952, GL_BM = 130048, GL_LR = 130560;

__device__ __forceinline__ void gla_chunk_geom(int gc, int hh, int& T, size_t& vbase) {
    if (gc < 64) { T = 256; vbase = ((size_t)((gc >> 2) * 4 + hh) * 128) * 256 + (gc & 3) * 64; }
    else { const int s = gc - 64; T = 2048; vbase = (size_t)MP * 512 + ((size_t)((s >> 5) * 4 + hh) * 128) * 2048 + (s & 31) * 64; }
}
__device__ __forceinline__ void gla_load_w(const float* w2, const float* b2, int hh, int d, float (&w)[16], float& bias) {
#pragma unroll
    for (int r = 0; r < 16; ++r) w[r] = w2[r * 256 + hh * 64 + d];
    bias = b2[hh * 64 + d];
}
__device__ __forceinline__ void gla_gates(const LAS unsigned char* lrs, const float (&w)[16], float bias, int ig, int dir, float (&g)[8]) {
#pragma unroll
    for (int i = 0; i < 8; ++i) {
        const LAS u32x4* row = (const LAS u32x4*)(lrs + (ig * 8 + i) * 64 + dir * 32);
        const u32x4 a = row[0], b = row[1];
        float x = bias;
        x += w[0] * bflo(a.x) + w[1] * bfhi(a.x) + w[2] * bflo(a.y) + w[3] * bfhi(a.y) + w[4] * bflo(a.z) + w[5] * bfhi(a.z) + w[6] * bflo(a.w) + w[7] * bfhi(a.w);
        x += w[8] * bflo(b.x) + w[9] * bfhi(b.x) + w[10] * bflo(b.y) + w[11] * bfhi(b.y) + w[12] * bflo(b.z) + w[13] * bfhi(b.z) + w[14] * bflo(b.w) + w[15] * bfhi(b.w);
        const float ls = fminf(x, 0.f) - __logf(1.0f + __expf(-fabsf(x)));
        g[i] = ls * (1.0f / 16.0f);
    }
}

__device__ __forceinline__ void gla_stepA(const Params& p, LAS unsigned char* lds, int unit, int jl) {
    const int tid = opaque_tid(), lane = tid & 63, w = tid >> 6, fr = lane & 15, fq = lane >> 4;
    const int gc = unit >> 2, hh = unit & 3, m0 = gc * 64;
    const bf16_t* qkv = (const bf16_t*)(p.ws + OFF_QKV); const bf16_t* vtg = (const bf16_t*)(p.ws + OFF_VTG);
    bf16_t* gst = (bf16_t*)(p.ws + OFF_GST); float* gam = (float*)(p.ws + OFF_GAM);
    int T; size_t vbase; gla_chunk_geom(gc, hh, T, vbase);
    const int d = tid & 63, ig = tid >> 6;
    u32x4 lr_reg = (u32x4){0u, 0u, 0u, 0u}, vt_reg[2];
    if (tid < 256) lr_reg = *(const u32x4*)(qkv + (size_t)(m0 + (tid >> 2)) * QKVP_AB + 2048 + (tid & 3) * 8);
#pragma unroll
    for (int it = 0; it < 2; ++it) { const int idx = tid + it * 512, e = idx >> 3, pc = idx & 7; vt_reg[it] = *(const u32x4*)(vtg + vbase + (size_t)e * T + pc * 8); }
    float wf[16], wb[16], biasf, biasb;
    gla_load_w(p.w2f + jl * 4096, p.b2f + jl * 256, hh, d, wf, biasf);
    gla_load_w(p.w2b + jl * 4096, p.b2b + jl * 256, hh, d, wb, biasb);
    unsigned short kraw[8];
#pragma unroll
    for (int i = 0; i < 8; ++i) kraw[i] = qkv[(size_t)(m0 + ig * 8 + i) * QKVP_AB + 1280 + hh * 64 + d];
    if (tid < 256) *(LAS u32x4*)(lds + GL_LR + (tid >> 2) * 64 + (tid & 3) * 16) = lr_reg;
#pragma unroll
    for (int it = 0; it < 2; ++it) { const int idx = tid + it * 512, e = idx >> 3, pc = idx & 7; *(LAS u32x4*)(lds + GL_VT + e * 144 + pc * 16) = vt_reg[it]; }
    __syncthreads();
    float g[2][8];
    gla_gates(lds + GL_LR, wf, biasf, ig, 0, g[0]);
    gla_gates(lds + GL_LR, wb, biasb, ig, 1, g[1]);
    LAS float* gt = (LAS float*)(lds + GL_GT);
#pragma unroll
    for (int dir = 0; dir < 2; ++dir) { float run = 0.f;
#pragma unroll
        for (int i = 0; i < 8; ++i) { run += g[dir][i]; g[dir][i] = run; }
        gt[(dir * 8 + ig) * 64 + d] = run; }
    __syncthreads();
    float kv[8];
#pragma unroll
    for (int i = 0; i < 8; ++i) kv[i] = bf2f(kraw[i]);
#pragma unroll
    for (int dir = 0; dir < 2; ++dir) {
        float off = 0.f, tot = 0.f;
#pragma unroll
        for (int q = 0; q < 8; ++q) { const float t = gt[(dir * 8 + q) * 64 + d]; tot += t; off += (q < ig) ? t : 0.f; }
        float dec[8];
#pragma unroll
        for (int i = 0; i < 8; ++i) {
            const float incl = off + g[dir][i];
            const float excl = off + (i > 0 ? g[dir][i > 0 ? i - 1 : 0] : 0.f);
            dec[i] = kv[i] * __expf(dir == 0 ? (tot - incl) : excl);
        }
        u32x4 wv; wv.x = cvt_pk_bf16(dec[0], dec[1]); wv.y = cvt_pk_bf16(dec[2], dec[3]); wv.z = cvt_pk_bf16(dec[4], dec[5]); wv.w = cvt_pk_bf16(dec[6], dec[7]);
        *(LAS u32x4*)(lds + (dir ? GL_KB : GL_KF) + d * 144 + ig * 16) = wv;
        if (ig == 0) gam[(size_t)((gc * 4 + hh) * 2 + dir) * 64 + d] = __expf(tot);
    }
    __syncthreads();
    bf16x8 vf[2];
#pragma unroll
    for (int ks = 0; ks < 2; ++ks) vf[ks] = *(const LAS bf16x8*)(lds + GL_VT + (w * 16 + fr) * 144 + ks * 64 + fq * 16);
#pragma unroll
    for (int dir = 0; dir < 2; ++dir) {
        bf16_t* dst = gst + (size_t)((gc * 4 + hh) * 2 + dir) * 8192;
#pragma unroll
        for (int dkt = 0; dkt < 4; ++dkt) {
            f32x4 a = (f32x4){0.f, 0.f, 0.f, 0.f};
#pragma unroll
            for (int ks = 0; ks < 2; ++ks) { const bf16x8 kf = *(const LAS bf16x8*)(lds + (dir ? GL_KB : GL_KF) + (dkt * 16 + fr) * 144 + ks * 64 + fq * 16); a = MFMA16(kf, vf[ks], a); }
            u32x2 o; o.x = cvt_pk_bf16(a[0], a[1]); o.y = cvt_pk_bf16(a[2], a[3]);
            *(u32x2*)(dst + (w * 16 + fr) * 64 + dkt * 16 + 4 * fq) = o;
        }
    }
    __syncthreads();
}

__device__ __forceinline__ void gla_stepB(const Params& p, int jl) {
    bf16_t* gst = (bf16_t*)(p.ws + OFF_GST); const float* gam = (const float*)(p.ws + OFF_GAM);
    const int gtid = blockIdx.x * 512 + opaque_tid(), gn = gridDim.x * 512;
    for (int item = gtid; item < 192 * 1024; item += gn) {
        const int combo = item >> 10, piece = item & 1023, dv = piece >> 3, dk0 = (piece & 7) * 8;
        const int dir = combo & 1, hh = (combo >> 1) & 3, sq = combo >> 3;
        const int nc = sq < 16 ? 4 : 32, gc0 = sq < 16 ? sq * 4 : 64 + (sq - 16) * 32;
        float S[8];
        if (sq < 16) {
#pragma unroll
            for (int i = 0; i < 8; ++i) S[i] = 0.f;
        } else {
            const float* s0 = (dir ? p.st_b : p.st_f) + ((size_t)((sq - 16) * 2 + jl) * 4 + hh) * 8192;
#pragma unroll
            for (int i = 0; i < 8; ++i) S[i] = s0[(dk0 + i) * 128 + dv];
        }
        for (int pb = 0; pb < nc; pb += 4) {
            u32x4 dl[4]; f32x4 g0[4], g1[4]; bf16_t* sp[4];
#pragma unroll
            for (int u = 0; u < 4; ++u) {
                const int pp = pb + u, c = dir ? nc - 1 - pp : pp;
                const size_t slot = (size_t)((gc0 + c) * 4 + hh) * 2 + dir;
                sp[u] = gst + slot * 8192 + dv * 64 + dk0;
                dl[u] = *(const u32x4*)sp[u];
                g0[u] = *(const f32x4*)(gam + slot * 64 + dk0); g1[u] = *(const f32x4*)(gam + slot * 64 + dk0 + 4);
            }
#pragma unroll
            for (int u = 0; u < 4; ++u) {
                u32x4 o; o.x = cvt_pk_bf16(S[0], S[1]); o.y = cvt_pk_bf16(S[2], S[3]); o.z = cvt_pk_bf16(S[4], S[5]); o.w = cvt_pk_bf16(S[6], S[7]);
                *(u32x4*)sp[u] = o;
                S[0] = g0[u][0] * S[0] + bflo(dl[u].x); S[1] = g0[u][1] * S[1] + bfhi(dl[u].x); S[2] = g0[u][2] * S[2] + bflo(dl[u].y); S[3] = g0[u][3] * S[3] + bfhi(dl[u].y);
                S[4] = g1[u][0] * S[4] + bflo(dl[u].z); S[5] = g1[u][1] * S[5] + bfhi(dl[u].z); S[6] = g1[u][2] * S[6] + bflo(dl[u].w); S[7] = g1[u][3] * S[7] + bfhi(dl[u].w);
            }
        }
        if (sq < 16) {
            float* o = p.out + (dir ? OUT_GB : OUT_GF) + ((size_t)(sq * 2 + jl) * 4 + hh) * 8192;
#pragma unroll
            for (int i = 0; i < 8; ++i) o[(dk0 + i) * 128 + dv] = S[i];
        }
    }
}

__device__ __forceinline__ void gla_stepC(const Params& p, LAS unsigned char* lds, int unit, int jl) {
    const int tid = opaque_tid(), lane = tid & 63, w = tid >> 6, fr = lane & 15, fq = lane >> 4;
    const int gc = unit >> 2, hh = unit & 3, m0 = gc * 64;
    const bf16_t* qkv = (const bf16_t*)(p.ws + OFF_QKV); const bf16_t* vtg = (const bf16_t*)(p.ws + OFF_VTG);
    const bf16_t* gst = (const bf16_t*)(p.ws + OFF_GST); bf16_t* O = (bf16_t*)(p.ws + OFF_O);
    int T; size_t vbase; gla_chunk_geom(gc, hh, T, vbase);
    const int d = tid & 63, ig = tid >> 6;
    u32x4 lr_reg = (u32x4){0u, 0u, 0u, 0u}, vt_reg[2];
    if (tid < 256) lr_reg = *(const u32x4*)(qkv + (size_t)(m0 + (tid >> 2)) * QKVP_AB + 2048 + (tid & 3) * 8);
#pragma unroll
    for (int it = 0; it < 2; ++it) { const int idx = tid + it * 512, e = idx >> 3, pc = idx & 7; vt_reg[it] = *(const u32x4*)(vtg + vbase + (size_t)e * T + pc * 8); }
    float wf[16], wb[16], biasf, biasb;
    gla_load_w(p.w2f + jl * 4096, p.b2f + jl * 256, hh, d, wf, biasf);
    gla_load_w(p.w2b + jl * 4096, p.b2b + jl * 256, hh, d, wb, biasb);
    unsigned short qraw[8], kraw[8];
#pragma unroll
    for (int i = 0; i < 8; ++i) { const bf16_t* rp = qkv + (size_t)(m0 + ig * 8 + i) * QKVP_AB + hh * 64 + d; qraw[i] = rp[1024]; kraw[i] = rp[1280]; }
    if (tid < 256) *(LAS u32x4*)(lds + GL_LR + (tid >> 2) * 64 + (tid & 3) * 16) = lr_reg;
#pragma unroll
    for (int it = 0; it < 2; ++it) { const int idx = tid + it * 512, e = idx >> 3, pc = idx & 7; *(LAS u32x4*)(lds + GL_VT + e * 144 + pc * 16) = vt_reg[it]; }
    __syncthreads();
    float g[2][8], gi[2][8];
    gla_gates(lds + GL_LR, wf, biasf, ig, 0, g[0]);
    gla_gates(lds + GL_LR, wb, biasb, ig, 1, g[1]);
    LAS float* gt = (LAS float*)(lds + GL_GT);
#pragma unroll
    for (int dir = 0; dir < 2; ++dir) { float run = 0.f;
#pragma unroll
        for (int i = 0; i < 8; ++i) { gi[dir][i] = g[dir][i]; run += g[dir][i]; g[dir][i] = run; }
        gt[(dir * 8 + ig) * 64 + d] = run; }
    __syncthreads();
    float qv[8], kv[8];
#pragma unroll
    for (int i = 0; i < 8; ++i) { qv[i] = bf2f(qraw[i]) * 0.125f; kv[i] = bf2f(kraw[i]); }
#pragma unroll
    for (int dir = 0; dir < 2; ++dir) {
        float off = 0.f, tot = 0.f, lo4 = 0.f;
#pragma unroll
        for (int q = 0; q < 8; ++q) { const float t = gt[(dir * 8 + q) * 64 + d]; tot += t; off += (q < ig) ? t : 0.f; lo4 += (q < 4) ? t : 0.f; }
        const float bmid = dir == 0 ? lo4 : (tot - lo4);
        LAS unsigned char* Qd = lds + (dir ? GL_QB : GL_QF); LAS unsigned char* Kd = lds + (dir ? GL_KB : GL_KF);
#pragma unroll
        for (int i = 0; i < 8; ++i) {
            const float b = dir == 0 ? (off + g[dir][i]) : (tot - (off + g[dir][i] - gi[dir][i]));
            const float e = b - bmid;
            const int tok = ig * 8 + i;
            *(LAS unsigned short*)(Qd + tok * 144 + d * 2) = f2bf1(qv[i] * __expf(e));
            *(LAS unsigned short*)(Kd + tok * 144 + d * 2) = f2bf1(kv[i] * __expf(-e));
        }
        if (ig == 0) ((LAS float*)(lds + GL_BM))[dir * 64 + d] = __expf(bmid);
    }
    __syncthreads();
#pragma unroll
    for (int dir = 0; dir < 2; ++dir) {
        const bf16_t* src = gst + (size_t)((gc * 4 + hh) * 2 + dir) * 8192;
        const LAS float* bm = (const LAS float*)(lds + GL_BM) + dir * 64;
#pragma unroll
        for (int it = 0; it < 2; ++it) {
            const int idx = tid + it * 512, dv = idx >> 3, pc = idx & 7;
            const u32x4 s = *(const u32x4*)(src + dv * 64 + pc * 8);
            const f32x4 e0 = *(const LAS f32x4*)(bm + pc * 8), e1 = *(const LAS f32x4*)(bm + pc * 8 + 4);
            u32x4 o; o.x = cvt_pk_bf16(bflo(s.x) * e0[0], bfhi(s.x) * e0[1]); o.y = cvt_pk_bf16(bflo(s.y) * e0[2], bfhi(s.y) * e0[3]);
            o.z = cvt_pk_bf16(bflo(s.z) * e1[0], bfhi(s.z) * e1[1]); o.w = cvt_pk_bf16(bflo(s.w) * e1[2], bfhi(s.w) * e1[3]);
            *(LAS u32x4*)(lds + (dir ? GL_SB : GL_SF) + dv * 144 + pc * 16) = o;
        }
    }
    __syncthreads();
    {
        const int dir = w >> 2, it = w & 3;
        const LAS unsigned char* Qd = lds + (dir ? GL_QB : GL_QF); const LAS unsigned char* Kd = lds + (dir ? GL_KB : GL_KF); const LAS unsigned char* Sd = lds + (dir ? GL_SB : GL_SF);
        bf16x8 qB[2];
#pragma unroll
        for (int ks = 0; ks < 2; ++ks) qB[ks] = *(const LAS bf16x8*)(Qd + (it * 16 + fr) * 144 + ks * 64 + fq * 16);
        f32x4 st[4];
        const int iq = 16 * it + fr;
#pragma unroll
        for (int jt = 0; jt < 4; ++jt) {
            st[jt] = (f32x4){0.f, 0.f, 0.f, 0.f};
#pragma unroll
            for (int ks = 0; ks < 2; ++ks) { const bf16x8 kf = *(const LAS bf16x8*)(Kd + (jt * 16 + fr) * 144 + ks * 64 + fq * 16); st[jt] = MFMA16(kf, qB[ks], st[jt]); }
#pragma unroll
            for (int j = 0; j < 4; ++j) { const int jj = 16 * jt + 4 * fq + j; const bool keep = dir == 0 ? (jj <= iq) : (jj >= iq); st[jt][j] = keep ? st[jt][j] : 0.f; }
        }
        bf16x8 pf[2];
#pragma unroll
        for (int kk = 0; kk < 2; ++kk) {
            u32x4 wv; wv.x = cvt_pk_bf16(st[2 * kk][0], st[2 * kk][1]); wv.y = cvt_pk_bf16(st[2 * kk][2], st[2 * kk][3]);
            wv.z = cvt_pk_bf16(st[2 * kk + 1][0], st[2 * kk + 1][1]); wv.w = cvt_pk_bf16(st[2 * kk + 1][2], st[2 * kk + 1][3]);
            pf[kk] = __builtin_bit_cast(bf16x8, wv);
        }
        f32x4 o[8];
#pragma unroll
        for (int dvt = 0; dvt < 8; ++dvt) {
            o[dvt] = (f32x4){0.f, 0.f, 0.f, 0.f};
#pragma unroll
            for (int kk = 0; kk < 2; ++kk) {
                const LAS unsigned char* vp = lds + GL_VT + (dvt * 16 + fr) * 144 + kk * 64 + fq * 8;
                const u32x2 lo = *(const LAS u32x2*)vp, hi = *(const LAS u32x2*)(vp + 32);
                u32x4 wv; wv.x = lo.x; wv.y = lo.y; wv.z = hi.x; wv.w = hi.y;
                o[dvt] = MFMA16(__builtin_bit_cast(bf16x8, wv), pf[kk], o[dvt]);
            }
#pragma unroll
            for (int ks = 0; ks < 2; ++ks) { const bf16x8 sf = *(const LAS bf16x8*)(Sd + (dvt * 16 + fr) * 144 + ks * 64 + fq * 16); o[dvt] = MFMA16(sf, qB[ks], o[dvt]); }
        }
        LAS float* ob = (LAS float*)(lds + GL_OB) + (it * 16 + fr) * 132;
        if (dir == 1) {
#pragma unroll
            for (int dvt = 0; dvt < 8; ++dvt) *(LAS f32x4*)(ob + dvt * 16 + 4 * fq) = o[dvt];
        }
        __syncthreads();
        if (dir == 0) {
            float ss = 0.f;
#pragma unroll
            for (int dvt = 0; dvt < 8; ++dvt) { o[dvt] = o[dvt] + *(const LAS f32x4*)(ob + dvt * 16 + 4 * fq); ss += (o[dvt][0] * o[dvt][0] + o[dvt][1] * o[dvt][1]) + (o[dvt][2] * o[dvt][2] + o[dvt][3] * o[dvt][3]); }
            ss += __shfl_xor(ss, 16); ss += __shfl_xor(ss, 32);
            const float rstd = rsqrtf(ss * (1.0f / 128.0f) + EPS);
            const int m = m0 + it * 16 + fr;
            const float* gn = p.gla_norm_g + jl * 512 + hh * 128;
#pragma unroll
            for (int dvt = 0; dvt < 8; ++dvt) {
                const int col = dvt * 16 + 4 * fq;
                const f32x4 gw = *(const f32x4*)(gn + col);
                const u32x2 rg = *(const u32x2*)(qkv + (size_t)m * QKVP_AB + 1536 + hh * 128 + col);
                const float y0 = o[dvt][0] * rstd * gw[0] * silu_f(bflo(rg.x)), y1 = o[dvt][1] * rstd * gw[1] * silu_f(bfhi(rg.x));
                const float y2 = o[dvt][2] * rstd * gw[2] * silu_f(bflo(rg.y)), y3 = o[dvt][3] * rstd * gw[3] * silu_f(bfhi(rg.y));
                u32x2 wv; wv.x = cvt_pk_bf16(y0, y1); wv.y = cvt_pk_bf16(y2, y3);
                *(u32x2*)(O + (size_t)m * DM + 512 + hh * 128 + col) = wv;
            }
        }
    }
    __syncthreads();
}

struct TItem { const float* W; bf16_t* WT; int K, N, k0, n0, drow0; };
__device__ __forceinline__ void titem_load(const TItem& t, float (&tv)[32], int lane) {
#pragma unroll
    for (int i = 0; i < 32; ++i) { const int kk = 2 * i + (lane >> 5); tv[i] = t.W[(size_t)(t.k0 + kk) * t.N + t.n0 + (lane & 31)]; }
}
__device__ __forceinline__ void titem_write(const TItem& t, const float (&tv)[32], LAS float* scr, int lane) {
#pragma unroll
    for (int i = 0; i < 32; ++i) { const int kk = 2 * i + (lane >> 5); scr[kk * 33 + (lane & 31)] = tv[i]; }
    asm volatile("s_waitcnt lgkmcnt(0)" ::: "memory");
    const int c = lane & 7;
#pragma unroll
    for (int j = 0; j < 4; ++j) { const int n = (lane >> 3) + 8 * j; const LAS float* s = scr + (8 * c) * 33 + n;
        u32x4 o; o.x = cvt_pk_bf16(s[0 * 33], s[1 * 33]); o.y = cvt_pk_bf16(s[2 * 33], s[3 * 33]); o.z = cvt_pk_bf16(s[4 * 33], s[5 * 33]); o.w = cvt_pk_bf16(s[6 * 33], s[7 * 33]);
        *(u32x4*)(t.WT + (size_t)(t.drow0 + n) * t.K + t.k0 + 8 * c) = o; }
    asm volatile("s_waitcnt lgkmcnt(0)" ::: "memory");
}

__device__ __forceinline__ void prologue(const Params& p, LAS unsigned char* lds) {
    const int tid = opaque_tid(), lane = tid & 63, w = tid >> 6;
    {
        LAS float* scr = (LAS float*)(lds + w * 16384);
        const int gw = blockIdx.x * 8 + w, NGW = gridDim.x * 8;
        constexpr int I_ABIN = 16 * 97, I_SQ = 16 * 32, I_CIN = 16 * 48, I_UP = 16 * 176, I_DN = 44 * 32;
        constexpr int N_ABIN = 2 * I_ABIN, N_ABOUT = 2 * I_SQ, N_CIN = 2 * I_CIN, N_COUT = 2 * I_SQ, N_UP = 4 * I_UP, N_DN = 4 * I_DN;
        constexpr int NITEMS = N_ABIN + N_ABOUT + N_CIN + N_COUT + N_UP + N_DN;
        auto decode = [&](int it, TItem& t) {
            int r = it;
            if (r < N_ABIN) { const int l = r / I_ABIN, q = r % I_ABIN, kb = q / 97, nb = q % 97;
                t = TItem{p.ab_w_in + (size_t)l * 1024 * AB_IN, (bf16_t*)(p.ws + OFF_WAB_IN) + (size_t)l * AB_INP * 1024, 1024, AB_IN, kb * 64, nb * 32, nb * 32}; return; }
            r -= N_ABIN;
            if (r < N_ABOUT) { const int l = r / I_SQ, q = r % I_SQ, kb = q / 32, nb = q % 32;
                t = TItem{p.ab_w_out + (size_t)l * 1024 * 1024, (bf16_t*)(p.ws + OFF_WAB_OUT) + (size_t)l * 1024 * 1024, 1024, 1024, kb * 64, nb * 32, nb * 32}; return; }
            r -= N_ABOUT;
            if (r < N_CIN) { const int l = r / I_CIN, q = r % I_CIN, kb = q / 48, nb = q % 48;
                const int n0 = nb * 32, pn = n0 >> 8, within = n0 & 255, wc = within >> 6, bj = (within >> 5) & 1;
                t = TItem{p.gqa_w_in + (size_t)l * 1024 * 1536, (bf16_t*)(p.ws + OFF_WC_IN) + (size_t)l * 1536 * 1024, 1024, 1536, kb * 64, n0, pn * 256 + bj * 128 + wc * 32}; return; }
            r -= N_CIN;
            if (r < N_COUT) { const int l = r / I_SQ, q = r % I_SQ, kb = q / 32, nb = q % 32;
                t = TItem{p.gqa_w_out + (size_t)l * 1024 * 1024, (bf16_t*)(p.ws + OFF_WC_OUT) + (size_t)l * 1024 * 1024, 1024, 1024, kb * 64, nb * 32, nb * 32}; return; }
            r -= N_COUT;
            if (r < N_UP) { const int l = r / I_UP, q = r % I_UP, kb = q / 176, nb = q % 176;
                const int n0 = nb * 32; int drow;
                if (n0 < DFF) drow = (n0 >> 7) * 256 + (n0 & 127); else { const int n1 = n0 - DFF; drow = (n1 >> 7) * 256 + 128 + (n1 & 127); }
                t = TItem{p.ffn_w_up + (size_t)l * 1024 * 5632, (bf16_t*)(p.ws + OFF_WUP) + (size_t)l * 5632 * 1024, 1024, 5632, kb * 64, n0, drow}; return; }
            r -= N_UP;
            { const int l = r / I_DN, q = r % I_DN, kb = q / 32, nb = q % 32;
                t = TItem{p.ffn_w_down + (size_t)l * DFF * 1024, (bf16_t*)(p.ws + OFF_WDN) + (size_t)l * 1024 * DFF, DFF, 1024, kb * 64, nb * 32, nb * 32}; }
        };
        TItem cur, nxt; float tvc[32], tvn[32];
        int it = gw;
        if (it < NITEMS) { decode(it, cur); titem_load(cur, tvc, lane); }
        while (it < NITEMS) {
            const int itn = it + NGW;
            if (itn < NITEMS) { decode(itn, nxt); titem_load(nxt, tvn, lane); }
            titem_write(cur, tvc, scr, lane);
            cur = nxt;
#pragma unroll
            for (int i = 0; i < 32; ++i) tvc[i] = tvn[i];
            it = itn;
        }
    }
    __syncthreads();
    {
        LAS float* sT = (LAS float*)lds;
        LAS float* red = (LAS float*)(lds + 49152);
        bool have = false;
        for (int unit = blockIdx.x; unit < 4 * 96; unit += gridDim.x) {
            if (!have) {
                for (int idx = tid; idx < 9 * 1024; idx += 512) { const int v = idx >> 10, k = idx & 1023; const float x = v == 0 ? p.c_ctx[k] : p.c[(v - 1) * 1024 + k]; sT[k * 12 + v] = silu_f(x); }
                have = true;
                __syncthreads();
            }
            const int l = unit / 96, n0 = (unit % 96) * 64, col = tid & 63, kg = tid >> 6;
            const float* wp = p.ada_w + ((size_t)l * 1024 + kg * 128) * 6144 + n0 + col;
            float a[9];
#pragma unroll
            for (int v = 0; v < 9; ++v) a[v] = 0.f;
#pragma unroll 32
            for (int k = 0; k < 128; ++k) {
                const float wv = wp[(size_t)k * 6144];
                const LAS f32x4* sp = (const LAS f32x4*)(sT + (kg * 128 + k) * 12);
                const f32x4 s0 = sp[0], s1 = sp[1], s2 = sp[2];
                a[0] += wv * s0[0]; a[1] += wv * s0[1]; a[2] += wv * s0[2]; a[3] += wv * s0[3];
                a[4] += wv * s1[0]; a[5] += wv * s1[1]; a[6] += wv * s1[2]; a[7] += wv * s1[3]; a[8] += wv * s2[0];
            }
#pragma unroll
            for (int v = 0; v < 9; ++v) red[(kg * 9 + v) * 64 + col] = a[v];
            __syncthreads();
            for (int idx = tid; idx < 576; idx += 512) { const int v = idx >> 6, cc = idx & 63; float s = p.ada_b[l * 6144 + n0 + cc];
#pragma unroll
                for (int q = 0; q < 8; ++q) s += red[(q * 9 + v) * 64 + cc];
                ((float*)(p.ws + OFF_MOD))[(size_t)(l * 9 + v) * 6144 + n0 + cc] = s; }
            __syncthreads();
        }
    }
    const int gtid = blockIdx.x * 512 + tid, gn = gridDim.x * 512;
    for (int idx = gtid; idx < 2048 * 16; idx += gn) {
        const int t = idx >> 4, f = idx & 15;
        const float inv = exp2f(-(float)f * (13.287712379549449f / 16.0f));
        const float ar = (float)(t >> 6) * inv, ac = (float)(t & 63) * inv;
        float* rc = (float*)(p.ws + OFF_ROPE); float* rs = rc + 2048 * 32;
        rc[t * 32 + f] = cosf(ar); rs[t * 32 + f] = sinf(ar); rc[t * 32 + 16 + f] = cosf(ac); rs[t * 32 + 16 + f] = sinf(ac);
    }
    {
        bf16_t* ck = (bf16_t*)(p.ws + OFF_CK_NA); bf16_t* cv = (bf16_t*)(p.ws + OFF_CVT_NA);
        for (int idx = gtid; idx < 2097152 / 2; idx += gn) { const float2 v = ((const float2*)p.cache_na_k)[idx]; ((unsigned*)ck)[idx] = cvt_pk_bf16(v.x, v.y); }
        for (int idx = gtid; idx < 2097152; idx += gn) { const int mat = idx >> 14, r = idx & 16383, d = r >> 8, key = r & 255; cv[idx] = f2bf1(p.cache_na_v[(size_t)mat * 16384 + key * 64 + d]); }
        bf16_t* gk = (bf16_t*)(p.ws + OFF_CK_GQ); bf16_t* gv = (bf16_t*)(p.ws + OFF_CVT_GQ);
        for (int idx = gtid; idx < 1048576 / 2; idx += gn) { const float2 v = ((const float2*)p.cache_gqa_k)[idx]; ((unsigned*)gk)[idx] = cvt_pk_bf16(v.x, v.y); }
        for (int idx = gtid; idx < 1048576; idx += gn) { const int mat = idx >> 14, r = idx & 16383, d = r >> 8, key = r & 255; gv[idx] = f2bf1(p.cache_gqa_v[(size_t)mat * 16384 + key * 64 + d]); }
    }
}

__device__ __forceinline__ void norm_pass(const Params& p, LAS unsigned char* lds, int layer, int which, bool first, const bf16_t* pend, int lr_jl) {
    const int tid0 = opaque_tid(), lane = tid0 & 63, w = tid0 >> 6;
    bf16_t* H = (bf16_t*)(p.ws + OFF_H);
    const float* mod = (const float*)(p.ws + OFF_MOD) + (size_t)layer * 9 * 6144 + which * 3072;
    const float* gw = (which ? p.norm_ffn_g : p.norm_mix_g) + layer * 1024;
    if (lr_jl >= 0) {
        const bf16_t* wl = (const bf16_t*)(p.ws + OFF_WAB_IN) + ((size_t)lr_jl * AB_INP + 3072) * 1024;
#pragma unroll
        for (int it = 0; it < 8; ++it) { const int idx = tid0 + it * 512, n = idx >> 7, pc = idx & 127; *(LAS u32x4*)(lds + n * 2064 + pc * 16) = *(const u32x4*)(wl + (size_t)n * 1024 + pc * 8); }
        __syncthreads();
    }
    const int NGW = gridDim.x * 8;
    f32x4 gv[4];
#pragma unroll
    for (int j = 0; j < 4; ++j) gv[j] = ((const f32x4*)gw)[lane + 64 * j];
    struct Row { f32x4 v[4], sh[4], sc[4]; };
    auto load_row = [&](int m, Row& r) {
        const float* xr = first ? (m < MP ? p.x_prompt + (size_t)m * DM : p.x_sample + (size_t)(m - MP) * DM) : p.out + (size_t)m * DM;
        const float* mv = mod + (size_t)cond_of_row(m) * 6144;
#pragma unroll
        for (int j = 0; j < 4; ++j) r.v[j] = ((const f32x4*)xr)[lane + 64 * j];
#pragma unroll
        for (int j = 0; j < 4; ++j) { r.sh[j] = ((const f32x4*)mv)[lane + 64 * j]; r.sc[j] = ((const f32x4*)(mv + 1024))[lane + 64 * j]; }
        if (pend != nullptr && m >= 16384) {
#pragma unroll
            for (int part = 0; part < 4; ++part)
#pragma unroll
                for (int j = 0; j < 4; ++j) { const u32x2 pw = ((const u32x2*)(pend + ((size_t)part * 4096 + (m - 16384)) * DM))[lane + 64 * j]; r.v[j] = r.v[j] + (f32x4){bflo(pw.x), bfhi(pw.x), bflo(pw.y), bfhi(pw.y)}; }
        }
    };
    Row cur, nxt;
    int m = blockIdx.x * 8 + w;
    if (m < MALL) load_row(m, cur);
    while (m < MALL) {
        const int mn = m + NGW;
        if (mn < MALL) load_row(mn, nxt);
        const bool addp = pend != nullptr && m >= 16384;
        float ss = 0.f;
#pragma unroll
        for (int j = 0; j < 4; ++j) ss += (cur.v[j][0] * cur.v[j][0] + cur.v[j][1] * cur.v[j][1]) + (cur.v[j][2] * cur.v[j][2] + cur.v[j][3] * cur.v[j][3]);
        ss = wave_sum(ss);
        const float rstd = rsqrtf(ss * (1.0f / 1024.0f) + EPS);
#pragma unroll
        for (int j = 0; j < 4; ++j) {
            const int c4 = lane + 64 * j;
            const f32x4 y = cur.v[j] * rstd * gv[j] * (cur.sc[j] + 1.0f) + cur.sh[j];
            u32x2 o; o.x = cvt_pk_bf16(y[0], y[1]); o.y = cvt_pk_bf16(y[2], y[3]);
            *(u32x2*)(H + (size_t)(1 + m) * DM + 4 * c4) = o;
            if (first || addp) ((f32x4*)(p.out + (size_t)m * DM))[c4] = cur.v[j];
        }
        cur = nxt; m = mn;
    }
    if (lr_jl >= 0) {
        asm volatile("s_waitcnt vmcnt(0)" ::: "memory");
        __syncthreads();
        const int fr = lane & 15, fq = lane >> 4, r8 = blockIdx.x * 8;
        bf16_t* qkv = (bf16_t*)(p.ws + OFF_QKV);
        for (int pr = w; r8 + 2 * pr * NGW < MALL; pr += 8) {
            const int m_lo = r8 + 2 * pr * NGW, m_hi = m_lo + NGW;
            const bool has_hi = m_hi < MALL;
            const int mrow = (fr < 8 || !has_hi) ? m_lo + (fr & 7) : m_hi + (fr & 7);
            const bf16_t* arow = H + (size_t)(1 + mrow) * DM + fq * 8;
            f32x4 acc0 = (f32x4){0.f, 0.f, 0.f, 0.f}, acc1 = (f32x4){0.f, 0.f, 0.f, 0.f};
#pragma unroll 8
            for (int ks = 0; ks < 32; ++ks) {
                const bf16x8 a = *(const bf16x8*)(arow + ks * 32);
                const bf16x8 b0 = *(const LAS bf16x8*)(lds + fr * 2064 + (ks * 32 + fq * 8) * 2), b1 = *(const LAS bf16x8*)(lds + (16 + fr) * 2064 + (ks * 32 + fq * 8) * 2);
                acc0 = MFMA16(a, b0, acc0); acc1 = MFMA16(a, b1, acc1);
            }
#pragma unroll
            for (int j = 0; j < 4; ++j) { const int i = 4 * fq + j; if (i < 8 || has_hi) { const int m = i < 8 ? m_lo + i : m_hi + i - 8; bf16_t* o = qkv + (size_t)m * QKVP_AB + 2048 + fr; o[0] = f2bf1(acc0[j]); o[16] = f2bf1(acc1[j]); } }
        }
    }
}
__device__ __forceinline__ void final_norm(const Params& p, const bf16_t* pend) {
    const int tid0 = opaque_tid(), lane = tid0 & 63, w = tid0 >> 6;
    for (int m = blockIdx.x * 8 + w; m < MALL; m += gridDim.x * 8) {
        float* xr = p.out + (size_t)m * DM;
        f32x4 v[4]; float ss = 0.f;
#pragma unroll
        for (int j = 0; j < 4; ++j) v[j] = ((const f32x4*)xr)[lane + 64 * j];
        if (pend != nullptr && m >= 16384) {
#pragma unroll
            for (int part = 0; part < 4; ++part)
#pragma unroll
                for (int j = 0; j < 4; ++j) { const u32x2 w = ((const u32x2*)(pend + ((size_t)part * 4096 + (m - 16384)) * DM))[lane + 64 * j]; v[j] = v[j] + (f32x4){bflo(w.x), bfhi(w.x), bflo(w.y), bfhi(w.y)}; }
        }
#pragma unroll
        for (int j = 0; j < 4; ++j) ss += (v[j][0] * v[j][0] + v[j][1] * v[j][1]) + (v[j][2] * v[j][2] + v[j][3] * v[j][3]);
        ss = wave_sum(ss);
        const float rstd = rsqrtf(ss * (1.0f / 1024.0f) + EPS);
#pragma unroll
        for (int j = 0; j < 4; ++j) { const int c4 = lane + 64 * j; ((f32x4*)xr)[c4] = v[j] * rstd * ((const f32x4*)p.final_g)[c4]; }
    }
}

__device__ __forceinline__ int na_rs(int r) { return min(max(r - 4, 0), 24); }

__device__ __forceinline__ void mixer_ab_phase1(const Params& p, LAS unsigned char* lds, int jl) {
    const int tid = opaque_tid(), lane = tid & 63, w = tid >> 6, fr = lane & 15;
    const bf16_t* qkv = (const bf16_t*)(p.ws + OFF_QKV); const bf16_t* vt = (const bf16_t*)(p.ws + OFF_VT); bf16_t* O = (bf16_t*)(p.ws + OFF_O);
    const bf16_t* ck = (const bf16_t*)(p.ws + OFF_CK_NA); const bf16_t* cv = (const bf16_t*)(p.ws + OFF_CVT_NA);
    constexpr int N_NAS = 8 * 8 * 4, N_NAP = 16 * 8, N_GA = 320 * 4;
    const bool bal = gridDim.x == 256;
    const int nseq = bal ? 7 : (N_NAS + N_NAP + N_GA + (int)gridDim.x - 1) / (int)gridDim.x;
    for (int si = 0; si < nseq; ++si) {
        int unit;
        if (bal) {
            const int q = blockIdx.x & 3;
            if (si == 0) unit = blockIdx.x;
            else if (si == 1) { if (q == 1 || q == 2) continue; unit = N_NAS + (blockIdx.x >> 2) * 2 + (q == 3 ? 1 : 0); }
            else unit = N_NAS + N_NAP + blockIdx.x + 256 * (si - 2);
        } else { unit = blockIdx.x + si * (int)gridDim.x; if (unit >= N_NAS + N_NAP + N_GA) break; }
        if (unit < N_NAS) {
            const int b = unit >> 5, h = (unit >> 2) & 7, r0 = (unit & 3) * 8;
            const int rlo = na_rs(r0), rhi = na_rs(r0 + 7) + 8, nkt = 4 + (rhi - rlo);
            const int r = r0 + w, myrs = na_rs(r);
            { const float* rp = p.na_rpb + ((size_t)jl * 8 + h) * 465; LAS float* bl = (LAS float*)(lds + AT_BIAS); for (int i = tid; i < 480; i += 512) { const int rr = i >> 5, cc = i & 31; bl[i] = cc < 31 ? rp[rr * 31 + cc] * LOG2E : -INFINITY; } }
            const size_t mat = (size_t)((b * 2 + jl) * 8 + h) * 16384;
            const size_t rowbase = (size_t)MP + (size_t)b * 2048;
            auto tile = [&](int kt, const bf16_t*& kp, int& kpi, const bf16_t*& vp, int& vpi) {
                if (kt < 4) { kp = ck + mat + kt * 64 * 64; kpi = 64; vp = cv + mat + kt * 64; vpi = 256; }
                else { const int kr = rlo + kt - 4; kp = qkv + (rowbase + kr * 64) * QKVP_AB + 512 + h * 64; kpi = QKVP_AB; vp = vt + (size_t)MP * 512 + ((size_t)(b * 8 + h) * 64) * 2048 + kr * 64; vpi = 2048; }
            };
            auto keyrow = [&](int kt) { return kt < 4 ? -1 : rlo + kt - 4; };
            auto active = [&](int kt) { if (kt < 4) return true; const int kr = rlo + kt - 4; return kr >= myrs && kr < myrs + 8; };
            const size_t mq = rowbase + r * 64 + fr;
            flash_unit<true>(lds, nkt, tile, keyrow, active, true, qkv + mq * QKVP_AB + h * 64, (size_t)16 * QKVP_AB, O + mq * DM + h * 64, (size_t)16 * DM, r);
        } else if (unit < N_NAS + N_NAP) {
            const int u2 = unit - N_NAS, b = u2 >> 3, h = u2 & 7;
            auto tile = [&](int kt, const bf16_t*& kp, int& kpi, const bf16_t*& vp, int& vpi) {
                kp = qkv + ((size_t)b * 256 + kt * 64) * QKVP_AB + 512 + h * 64; kpi = QKVP_AB; vp = vt + ((size_t)(b * 8 + h) * 64) * 256 + kt * 64; vpi = 256; };
            auto keyrow = [&](int) { return -1; };
            auto active = [&](int) { return true; };
            const size_t mq = (size_t)b * 256 + 64 * (w & 3) + fr;
            flash_unit<false>(lds, 4, tile, keyrow, active, w < 4, qkv + mq * QKVP_AB + h * 64, (size_t)16 * QKVP_AB, O + mq * DM + h * 64, (size_t)16 * DM, 0);
        } else {
            gla_stepA(p, lds, unit - N_NAS - N_NAP, jl);
        }
    }
}

__device__ __forceinline__ void mixer_c_phase(const Params& p, LAS unsigned char* lds, int jl) {
    const int tid = opaque_tid(), lane = tid & 63, w = tid >> 6, fr = lane & 15;
    const bf16_t* qkv = (const bf16_t*)(p.ws + OFF_QKV); const bf16_t* vt = (const bf16_t*)(p.ws + OFF_VT); bf16_t* O = (bf16_t*)(p.ws + OFF_O);
    const bf16_t* ck = (const bf16_t*)(p.ws + OFF_CK_GQ); const bf16_t* cv = (const bf16_t*)(p.ws + OFF_CVT_GQ);
    constexpr int N_S = 8 * 4 * 16, N_P = 16 * 4 * 4;
    auto keyrow = [&](int) { return -1; };
    auto active = [&](int) { return true; };
    const bool xsw = gridDim.x == 256;
    const int nrounds = xsw ? 3 : (N_S + N_P + (int)gridDim.x - 1) / (int)gridDim.x;
    for (int ri = 0; ri < nrounds; ++ri) {
        int unit;
        if (xsw) { const int x = blockIdx.x & 7, j = blockIdx.x >> 3;
            if (ri < 2) unit = ((x * 2 + (j >> 4) + 16 * ri) << 4) + (j & 15);
            else unit = N_S + ((x * 8 + (j >> 2)) << 2) + (j & 3); }
        else { unit = blockIdx.x + ri * (int)gridDim.x; if (unit >= N_S + N_P) break; }
        if (unit < N_S) {
            const int b = unit >> 6, kvh = (unit >> 4) & 3, qb = unit & 15;
            const size_t mat = (size_t)((b * 2 + jl) * 4 + kvh) * 16384;
            const size_t rowbase = (size_t)MP + (size_t)b * 2048;
            auto tile = [&](int kt, const bf16_t*& kp, int& kpi, const bf16_t*& vp, int& vpi) {
                if (kt < 4) { kp = ck + mat + kt * 64 * 64; kpi = 64; vp = cv + mat + kt * 64; vpi = 256; }
                else { kp = qkv + (rowbase + (kt - 4) * 64) * QKVP_C + 1024 + kvh * 64; kpi = QKVP_C; vp = vt + (size_t)MP * 256 + ((size_t)(b * 4 + kvh) * 64) * 2048 + (kt - 4) * 64; vpi = 2048; }
            };
            const int head = kvh * 4 + (w >> 1);
            const size_t mq = rowbase + qb * 128 + 64 * (w & 1) + fr;
            flash_unit<false>(lds, 36, tile, keyrow, active, true, qkv + mq * QKVP_C + head * 64, (size_t)16 * QKVP_C, O + mq * DM + head * 64, (size_t)16 * DM, 0);
        } else {
            const int u2 = unit - N_S, b = u2 >> 4, kvh = (u2 >> 2) & 3, qb = u2 & 3;
            auto tile = [&](int kt, const bf16_t*& kp, int& kpi, const bf16_t*& vp, int& vpi) {
                kp = qkv + ((size_t)b * 256 + kt * 64) * QKVP_C + 1024 + kvh * 64; kpi = QKVP_C; vp = vt + ((size_t)(b * 4 + kvh) * 64) * 256 + kt * 64; vpi = 256; };
            const int head = kvh * 4 + (w & 3);
            const size_t mq = (size_t)b * 256 + qb * 64 + fr;
            flash_unit<false>(lds, 4, tile, keyrow, active, w < 4, qkv + mq * QKVP_C + head * 64, (size_t)16 * QKVP_C, O + mq * DM + head * 64, (size_t)16 * DM, 0);
        }
    }
}

#define XB_TMO      128
#define XB_XCNT(j)  (256  + 64 * (j))
#define XB_XSUB(j)  (1280 + 64 * (j))
#define XB_XGEN(j)  (2304 + 64 * (j))
#define XB_TOP      3328
#define XB_TOPGEN   3392
#define XCD_BAR_WORDS 3456
#define XB_SPIN_CAP (1u << 18)
__device__ __forceinline__ unsigned xb_ld(unsigned* p)              { return __hip_atomic_load(p, __ATOMIC_RELAXED, __HIP_MEMORY_SCOPE_AGENT); }
__device__ __forceinline__ unsigned xb_add(unsigned* p, unsigned v) { return __hip_atomic_fetch_add(p, v, __ATOMIC_RELAXED, __HIP_MEMORY_SCOPE_AGENT); }
__device__ __forceinline__ unsigned xb_xcc_id() { return (unsigned)__builtin_amdgcn_s_getreg((3 << 11) | 20) & 0xFu; }
#define XB_SPIN(cond, bar) do { unsigned _sp = 0; while (cond) { __builtin_amdgcn_s_sleep(1); \
    if ((++_sp & 255u) == 0u) { if (xb_ld(&(bar)[XB_TMO])) break; if (_sp > XB_SPIN_CAP) { atomicAdd(&(bar)[XB_TMO], 1u); break; } } } } while (0)
struct XcdBarrier { unsigned* bar; unsigned x; volatile LAS unsigned* st; };
__device__ __forceinline__ XcdBarrier xcd_barrier_post(unsigned* bar, volatile LAS unsigned* st) {
    XcdBarrier b; b.bar = bar; b.x = xb_xcc_id(); b.st = st;
    if (threadIdx.x == 0) (void)xb_add(&bar[XB_XCNT(b.x)], 1u);
    return b;
}
__device__ __forceinline__ void xcd_barrier_complete(unsigned* bar, unsigned x, unsigned& nloc, unsigned& nx) {
    const unsigned G = gridDim.x * gridDim.y * gridDim.z;
    unsigned sum, cnt, mine, sp = 0u;
    for (;;) {
        sum = 0u; cnt = 0u; mine = 0u;
#pragma unroll
        for (unsigned j = 0; j < 16; ++j) { const unsigned c = xb_ld(&bar[XB_XCNT(j)]); sum += c; cnt += (c > 0u) ? 1u : 0u; mine = (j == x) ? c : mine; }
        if (sum == G) break;
        __builtin_amdgcn_s_sleep(1);
        if ((++sp & 255u) == 0u) { if (xb_ld(&bar[XB_TMO])) break; if (sp > XB_SPIN_CAP) { atomicAdd(&bar[XB_TMO], 1u); break; } }
    }
    nloc = mine > 0u ? mine : 1u; nx = cnt > 0u ? cnt : 1u;
}
__device__ __forceinline__ void xcd_barrier(const XcdBarrier& b) {
    asm volatile("s_waitcnt vmcnt(0) lgkmcnt(0)" ::: "memory");
    __syncthreads();
    if (threadIdx.x == 0) {
        unsigned* bar = b.bar;
        __builtin_amdgcn_s_waitcnt(0);
        unsigned nloc = b.st[0], nx = b.st[1];
        if (nloc == 0u) { xcd_barrier_complete(bar, b.x, nloc, nx); b.st[0] = nloc; b.st[1] = nx; }
        const unsigned old = xb_add(&bar[XB_XSUB(b.x)], 1u);
        const unsigned gen = old / nloc;
        if (old + 1u == (gen + 1u) * nloc) {
            __builtin_amdgcn_fence(__ATOMIC_RELEASE, "agent");
            asm volatile("s_waitcnt vmcnt(0)" ::: "memory");
            const unsigned og = xb_add(&bar[XB_TOP], 1u);
            const unsigned tg = og / nx;
            if (og + 1u == (tg + 1u) * nx) xb_add(&bar[XB_TOPGEN], 1u);
            else XB_SPIN(xb_ld(&bar[XB_TOPGEN]) == tg, bar);
            __builtin_amdgcn_fence(__ATOMIC_ACQUIRE, "agent");
            xb_add(&bar[XB_XGEN(b.x)], 1u);
            asm volatile("s_waitcnt vmcnt(0)" ::: "memory");
        } else {
            XB_SPIN(xb_ld(&bar[XB_XGEN(b.x)]) == gen, bar);
            __builtin_amdgcn_fence(__ATOMIC_ACQUIRE, "agent");
            asm volatile("s_waitcnt vmcnt(0)" ::: "memory");
        }
    }
    __syncthreads();
}

__global__ void __launch_bounds__(512) mega_fwd(Params p) {
    extern __shared__ __attribute__((aligned(16))) unsigned char lds_raw[];
    LAS unsigned char* lds = (LAS unsigned char*)lds_raw;
    cg::grid_group grid = cg::this_grid();
    volatile LAS unsigned* xst = (volatile LAS unsigned*)(lds + 147440);
    if (threadIdx.x == 0) { xst[0] = 0u; xst[1] = 0u; }
    (void)xcd_barrier_post((unsigned*)p.ws, xst);
#define GSYNC() do { XcdBarrier xb_; xb_.bar = (unsigned*)p.ws; xb_.x = xb_xcc_id(); xb_.st = (volatile LAS unsigned*)(lds + 147440); xcd_barrier(xb_); } while (0)
    const int G = gridDim.x, c = blockIdx.x;
    const float* mod = (const float*)(p.ws + OFF_MOD);
    const bf16_t* H = (const bf16_t*)(p.ws + OFF_H);
    bf16_t* QKV = (bf16_t*)(p.ws + OFF_QKV); bf16_t* VT = (bf16_t*)(p.ws + OFF_VT); bf16_t* VTG = (bf16_t*)(p.ws + OFF_VTG);
    const bf16_t* Ob = (const bf16_t*)(p.ws + OFF_O);
    const bool split = gridDim.x == 256;
    bf16_t* pend_dn = (bf16_t*)(p.ws + OFF_O);
    bf16_t* pend_op = (bf16_t*)(p.ws + OFF_QKV);

#ifndef PM
#define PM 0xffff
#endif
#ifndef DUP
#define DUP 0
#endif
#define REP(bit) for (int rep_ = 0; rep_ < ((DUP & (bit)) ? 2 : 1); ++rep_)
    REP(1) if (PM & 1) prologue(p, lds);
    GSYNC();
    if (p.ws == nullptr) grid.sync();
    for (int layer = 0; layer < 4; ++layer) {
        const int jl = layer >> 1;
        if (PM & 2) norm_pass(p, lds, layer, 0, layer == 0, (layer > 0 && split) ? pend_dn : nullptr, (layer & 1) ? -1 : jl);
        GSYNC();
        if ((layer & 1) == 0) {
            REP(2) if (PM & 4) { pg8::Gemm g{H + DM, (const bf16_t*)(p.ws + OFF_WAB_IN) + (size_t)jl * AB_INP * 1024, MALL, 3072, 1024}; pg8::StaticOrder S; S.init(80, 12, G, c, 16);
              EpiABIn E{QKV, VT, VTG, p.out + OUT_NAK, p.out + OUT_NAV, jl};
              pg8::gemm_phase<EpiABIn, pg8::StaticOrder, true, true, false>(lds, g, S, E); }
            GSYNC();
            REP(4) if (PM & 8) mixer_ab_phase1(p, lds, jl);
            GSYNC();
            if (PM & 16) gla_stepB(p, jl);
            GSYNC();
            REP(4) if (PM & 32) for (int unit = blockIdx.x; unit < 320 * 4; unit += gridDim.x) gla_stepC(p, lds, unit, jl);
            GSYNC();
            if (PM & 64) { pg8::Gemm g{Ob, (const bf16_t*)(p.ws + OFF_WAB_OUT) + (size_t)jl * 1024 * 1024, MALL, 1024, 1024}; pg8::TailSplitOrder S; S.b.init(split ? 64 : 80, 4, G, c, 16); S.split = split;
              EpiRes E{p.out, mod + (size_t)layer * 9 * 6144 + 2048, pend_op};
              pg8::gemm_phase<EpiRes, pg8::TailSplitOrder, true, true, false>(lds, g, S, E); }
        } else {
            REP(2) if (PM & 128) { pg8::Gemm g{H + DM, (const bf16_t*)(p.ws + OFF_WC_IN) + (size_t)jl * 1536 * 1024, MALL, 1536, 1024}; pg8::StaticOrder S; S.init(80, 6, G, c, 16);
              EpiCIn E{QKV, VT, p.out + OUT_GQK, p.out + OUT_GQV, p.qn_g + jl * 64, p.kn_g + jl * 64, (const float*)(p.ws + OFF_ROPE), (const float*)(p.ws + OFF_ROPE) + 2048 * 32, jl};
              pg8::gemm_phase<EpiCIn, pg8::StaticOrder, true, true, false>(lds, g, S, E); }
            GSYNC();
            REP(16) if (PM & 256) mixer_c_phase(p, lds, jl);
            GSYNC();
            if (PM & 64) { pg8::Gemm g{Ob, (const bf16_t*)(p.ws + OFF_WC_OUT) + (size_t)jl * 1024 * 1024, MALL, 1024, 1024}; pg8::TailSplitOrder S; S.b.init(split ? 64 : 80, 4, G, c, 16); S.split = split;
              EpiRes E{p.out, mod + (size_t)layer * 9 * 6144 + 2048, pend_op};
              pg8::gemm_phase<EpiRes, pg8::TailSplitOrder, true, true, false>(lds, g, S, E); }
        }
        GSYNC();
        if (PM & 2) norm_pass(p, lds, layer, 1, false, split ? pend_op : nullptr, -1);
        GSYNC();
        REP(2) if (PM & 512) { pg8::Gemm g{H, (const bf16_t*)(p.ws + OFF_WUP) + (size_t)layer * 5632 * 1024, MALL, 5632, 1024}; pg8::StaticOrder S; S.init(81, 22, G, c, 16);
          EpiUp E{QKV  , p.conv_w + (size_t)layer * 3 * 5632, p.conv_b + (size_t)layer * 5632};
          pg8::Unit uu;
          for (int i = 0; S.next(i, uu); ++i) { OneUnit S1{uu}; pg8::gemm_phase<EpiUp, OneUnit, false, true, true>(lds, g, S1, E); } }
        GSYNC();
        if (PM & 64) { pg8::Gemm g{QKV, (const bf16_t*)(p.ws + OFF_WDN) + (size_t)layer * 1024 * DFF, MALL, 1024, DFF}; pg8::TailSplitOrder S; S.b.init(split ? 64 : 80, 4, G, c, 44); S.split = split;
          EpiRes E{p.out, mod + (size_t)layer * 9 * 6144 + 5120, pend_dn};
          pg8::gemm_phase<EpiRes, pg8::TailSplitOrder, true, true, false>(lds, g, S, E); }
        GSYNC();
    }
    if (PM & 2) final_norm(p, split ? pend_dn : nullptr);

}

extern "C" void kernel_launch(void* const* d_in, const int* in_sizes, int n_in, void* d_out, int out_size, void* d_ws, size_t ws_size, hipStream_t stream) {
    static int grid = 0;
    if (grid == 0) {
        if (n_in != 31 || ws_size < WS_NEED) { fprintf(stderr, "kernel_launch: unexpected n_in %d or ws_size %zu (< %zu)\n", n_in, ws_size, (size_t)WS_NEED); grid = -1; return; }
        int dev = 0, cus = 0, per_cu = 0;
        hipGetDevice(&dev);
        hipDeviceGetAttribute(&cus, hipDeviceAttributeMultiprocessorCount, dev);
        if (hipFuncSetAttribute((const void*)mega_fwd, hipFuncAttributeMaxDynamicSharedMemorySize, LDS_BYTES) != hipSuccess) { fprintf(stderr, "kernel_launch: hipFuncSetAttribute failed\n"); grid = -1; return; }
        hipOccupancyMaxActiveBlocksPerMultiprocessor(&per_cu, (const void*)mega_fwd, 512, LDS_BYTES);
        (void)hipGetLastError();
        if (per_cu < 1) fprintf(stderr, "kernel_launch: occupancy query says %d blocks/CU\n", per_cu);
        grid = cus;
    }
    if (grid < 0) return;
    Params p{};
    const float** pp = (const float**)&p;
    for (int i = 0; i < 31; ++i) pp[i] = (const float*)d_in[i];
    p.out = (float*)d_out; p.ws = (unsigned char*)d_ws;
    (void)hipMemsetAsync(d_ws, 0, 16384, stream);
    void* args[] = {&p};
    hipError_t e = hipLaunchCooperativeKernel((const void*)mega_fwd, dim3(grid), dim3(512), args, LDS_BYTES, stream);
    if (e != hipSuccess) fprintf(stderr, "cooperative launch failed: %s (grid %d)\n", hipGetErrorString(e), grid);
}
```

```cpp
#include <hip/hip_runtime.h>
#include <hip/hip_cooperative_groups.h>
#include <cstdio>
#include <cstdint>
namespace cg = cooperative_groups;

#define LAS __attribute__((address_space(3)))
typedef unsigned short bf16_t;
typedef short bf16x8 __attribute__((ext_vector_type(8)));
typedef short s16x4 __attribute__((ext_vector_type(4)));
typedef float f32x4 __attribute__((ext_vector_type(4)));
typedef unsigned u32x4 __attribute__((ext_vector_type(4)));
typedef unsigned u32x2 __attribute__((ext_vector_type(2)));

constexpr int DM = 1024, MP = 4096, MSAMP = 16384, MALL = 20480;
constexpr int AB_IN = 3104, AB_INP = 3328, QKVP_AB = 2080, QKVP_C = 1280, DFF = 2816;
constexpr float QSCALE = 0.125f * 1.4426950408889634f;
constexpr float LOG2E = 1.4426950408889634f;
constexpr float EPS = 1e-6f;
constexpr size_t OUT_NAK = 20971520, OUT_NAV = 25165824, OUT_GF = 29360128, OUT_GB = 30408704, OUT_GQK = 31457280, OUT_GQV = 33554432;
constexpr size_t MiB = 1u << 20;
constexpr size_t OFF_MOD = 1 * MiB, OFF_ROPE = 2 * MiB, OFF_GAM = 3 * MiB, OFF_CK_NA = 4 * MiB, OFF_CVT_NA = 8 * MiB, OFF_CK_GQ = 12 * MiB, OFF_CVT_GQ = 14 * MiB;
constexpr size_t OFF_WAB_IN = 16 * MiB, OFF_WAB_OUT = 29 * MiB, OFF_WC_IN = 33 * MiB, OFF_WC_OUT = 39 * MiB, OFF_WUP = 43 * MiB, OFF_WDN = 87 * MiB;
constexpr size_t OFF_H = 109 * MiB, OFF_QKV = 150 * MiB, OFF_VT = 232 * MiB, OFF_VTG = 252 * MiB, OFF_O = 272 * MiB, OFF_GST = 312 * MiB, WS_NEED = 352 * MiB;
constexpr int LDS_BYTES = 147456;

struct Params {
    const float *x_prompt, *x_sample, *cache_na_k, *cache_na_v, *st_f, *st_b, *cache_gqa_k, *cache_gqa_v, *c, *c_ctx,
        *ada_w, *ada_b, *norm_mix_g, *norm_ffn_g, *ab_w_in, *ab_w_out, *na_rpb, *w2f, *b2f, *w2b, *b2b, *gla_norm_g,
        *gqa_w_in, *gqa_w_out, *qn_g, *kn_g, *ffn_w_up, *conv_w, *conv_b, *ffn_w_down, *final_g;
    float* out; unsigned char* ws;
};

typedef float f32x2_t __attribute__((ext_vector_type(2)));
typedef __bf16 bf16x2_t __attribute__((ext_vector_type(2)));
__device__ __forceinline__ unsigned cvt_pk_bf16(float lo, float hi) { f32x2_t v = {lo, hi}; bf16x2_t b = __builtin_convertvector(v, bf16x2_t); return __builtin_bit_cast(unsigned, b); }
__device__ __forceinline__ float bf2f(unsigned short b) { return __builtin_bit_cast(float, (unsigned)b << 16); }
__device__ __forceinline__ float bflo(unsigned w) { return __builtin_bit_cast(float, w << 16); }
__device__ __forceinline__ float bfhi(unsigned w) { return __builtin_bit_cast(float, w & 0xffff0000u); }
__device__ __forceinline__ unsigned short f2bf1(float f) { return (unsigned short)(cvt_pk_bf16(f, 0.f) & 0xffffu); }
__device__ __forceinline__ float silu_f(float x) { return x * __builtin_amdgcn_rcpf(1.0f + __expf(-x)); }
__device__ __forceinline__ float wave_sum(float v) {
#pragma unroll
    for (int o = 1; o < 64; o <<= 1) v += __shfl_xor(v, o);
    return v;
}
__device__ __forceinline__ int opaque_tid() { int t = threadIdx.x; asm volatile("" : "+v"(t)); return t; }
__device__ __forceinline__ int cond_of_row(int m) { return m < MP ? 0 : 1 + ((m - MP) >> 11); }

namespace pg8 {
#define PG8_LAS __attribute__((address_space(3)))
constexpr int BM = 256, BK = 64, HALF = 128, HTB = HALF * BK * 2, STAGE_BYTES = 8 * HTB, NXCD = 8, WGM = 8;
__host__ __device__ __forceinline__ int lds_byte(int r, int c) { const int st = (r >> 4) * 2 + (c >> 5), rr = r & 15, cc = c & 31, ob = rr * 64 + cc * 2; return st * 1024 + (ob ^ (((ob >> 9) & 1) << 5)); }
__host__ __device__ __forceinline__ void stage_rc(int b, int& R, int& C) { const int st = b / 1024, sb = b % 1024, swz = sb ^ (((sb >> 9) & 1) << 5); R = (st >> 1) * 16 + swz / 64; C = (st & 1) * 32 + (swz % 64) / 2; }
__host__ __device__ __forceinline__ int perm32(int rho) { const int n = rho >> 4, i = rho & 15; return 8 * (i >> 2) + 4 * n + (i & 3); }
struct Unit { int pm, pn, k0, nk, part; };
struct Gemm { const bf16_t* A; const bf16_t* Bt; int M, N, K; };
struct StaticOrder {
    int nM, nN, nwg, G, c, ntK;
    __host__ __device__ __forceinline__ void init(int nM_, int nN_, int G_, int c_, int ntK_) { nM = nM_; nN = nN_; nwg = nM * nN; G = G_; c = c_; ntK = ntK_; }
    __host__ __device__ __forceinline__ void map(int L, Unit& u) const {
        int wgid = L; { const int q = nwg / NXCD, r = nwg % NXCD, xcd = wgid % NXCD, off = wgid / NXCD; wgid = (xcd < r ? xcd * (q + 1) : r * (q + 1) + (xcd - r) * q) + off; }
        const int nig = WGM * nN, gid = wgid / nig, fm = gid * WGM, gsz = (nM - fm) < WGM ? (nM - fm) : WGM;
        u.pm = fm + ((wgid % nig) % gsz); u.pn = (wgid % nig) / gsz; u.k0 = 0; u.nk = ntK; u.part = -1;
    }
    __host__ __device__ __forceinline__ bool next(int i, Unit& u) const {
        const long L = (long)i * G + c; if (L >= nwg) return false;
        map((int)L, u); return true;
    }
    __device__ __forceinline__ void a_ready(const Unit&) const {}
    __device__ __forceinline__ void done(const Unit&) const {}
};
struct TailSplitOrder {
    StaticOrder b;
    bool split;
    __device__ __forceinline__ bool next(int i, Unit& u) const {
        const bool r0 = (i == 0) || !split;
        const long L = (long)i * b.G + b.c;
        Unit a; b.map((int)(L < b.nwg ? L : 0), a);
        const int part = b.c & 3;
        const int q8 = b.ntK >> 2, q = q8 & ~1, extra = (b.ntK - 4 * q) >> 1;
        const bool eq = (b.ntK & 7) == 0;
        const int nk1 = eq ? q8 : q + (part < extra ? 2 : 0);
        const int k01 = eq ? part * q8 : part * q + 2 * (part < extra ? part : extra);
        u.pm = r0 ? a.pm : 64 + (b.c >> 4); u.pn = r0 ? a.pn : ((b.c >> 2) & 3);
        u.k0 = r0 ? 0 : k01; u.nk = r0 ? b.ntK : nk1; u.part = r0 ? -1 : part;
        return split ? (i <= 1) : (L < b.nwg);
    }
    __device__ __forceinline__ void a_ready(const Unit&) const {}
    __device__ __forceinline__ void done(const Unit&) const {}
};
template <class Epi, class Sched, bool ALIGN_EPI = false, bool SP2 = false, bool AREMAP = false>
__device__ __forceinline__ void gemm_phase(PG8_LAS unsigned char* lds, const Gemm g, const Sched& S, const Epi& E) {
    int tid_ = threadIdx.x; asm volatile("" : "+v"(tid_));
    const int tid = tid_, wid = __builtin_amdgcn_readfirstlane(tid >> 6), lane = tid & 63, wr = wid >> 2, wc = wid & 3, fr = lane & 15, fq = lane >> 4;
    const int K = g.K;
    unsigned voffA[2], voffB[2];
#pragma unroll
    for (int i = 0; i < 2; ++i) { int R, C; stage_rc(tid * 16 + i * 8192, R, C); const int Rb = Epi::PERM ? ((R & ~31) + perm32(R & 31)) : R;
        voffA[i] = (unsigned)(R * K + C) * 2u; voffB[i] = (unsigned)(Rb * K + C) * 2u; }
    const size_t kstep = (size_t)(BK * 2);
    const size_t hstep = (size_t)HALF * K * 2;
    const size_t tstep = 2 * hstep; const size_t hstepA = hstep; const size_t tstepA = AREMAP ? (size_t)254 * K * 2 : tstep;
    const unsigned ldsw = (unsigned)wid * 1024u;
    const int aoff = lds_byte(wr * 64 + fr, fq * 8), boff = lds_byte(wc * 32 + fr, fq * 8);
#define PG8_SA(b, h) (((b) * 2 + (h)) * HTB)
#define PG8_SB(b, h) ((4 + (b) * 2 + (h)) * HTB)
#define PG8_STAGE(bufoff, gbase, voff) do { _Pragma("unroll") for (int _i = 0; _i < 2; ++_i) \
        __builtin_amdgcn_global_load_lds((const unsigned*)((const char*)(gbase) + (voff)[_i]), (PG8_LAS unsigned*)(lds + (bufoff) + ldsw + _i * 8192), 16, 0, 0); } while (0)
#define PG8_LDA(dst, b, h) do { _Pragma("unroll") for (int m = 0; m < 4; ++m) _Pragma("unroll") for (int k = 0; k < 2; ++k) dst[m][k] = *(const PG8_LAS bf16x8*)(lds + PG8_SA(b, h) + aoff + m * 2048 + k * 1024); } while (0)
#define PG8_LDB(dst, b, h) do { _Pragma("unroll") for (int n = 0; n < 2; ++n) _Pragma("unroll") for (int k = 0; k < 2; ++k) dst[n][k] = *(const PG8_LAS bf16x8*)(lds + PG8_SB(b, h) + boff + n * 2048 + k * 1024); } while (0)
#define PG8_MMA(ai, bj, At, Bt) do { __builtin_amdgcn_s_setprio(1); _Pragma("unroll") for (int m = 0; m < 4; ++m) _Pragma("unroll") for (int n = 0; n < 2; ++n) _Pragma("unroll") for (int k = 0; k < 2; ++k) \
        acc[ai][bj][m][n] = __builtin_amdgcn_mfma_f32_16x16x32_bf16(Bt[n][k], At[m][k], acc[ai][bj][m][n], 0, 0, 0); __builtin_amdgcn_s_setprio(0); } while (0)
#define PG8_WAIT_V(n) asm volatile("s_waitcnt vmcnt(" #n ")" ::: "memory")
#define PG8_WAIT_L(n) asm volatile("s_waitcnt lgkmcnt(" #n ")" ::: "memory")
#define PG8_BAR __builtin_amdgcn_s_barrier()
#define PG8_SCHED __builtin_amdgcn_sched_barrier(0)
    Unit cur, nxt; int ui = 0;
    if (!S.next(0, cur)) return;
    f32x4 acc[2][2][4][2];
#pragma unroll
    for (int a = 0; a < 2; ++a)
#pragma unroll
        for (int b = 0; b < 2; ++b)
#pragma unroll
            for (int m = 0; m < 4; ++m)
#pragma unroll
                for (int n = 0; n < 2; ++n) acc[a][b][m][n] = (f32x4){0.f, 0.f, 0.f, 0.f};
    bf16x8 At[4][2], B0[2][2], B1[2][2];
    const char* cA = (const char*)g.A + (size_t)cur.pm * tstepA + (size_t)cur.k0 * (BK * 2); const char* cB = (const char*)g.Bt + (size_t)cur.pn * tstep + (size_t)cur.k0 * (BK * 2);
    S.a_ready(cur);
    if constexpr (SP2) {
        PG8_STAGE(PG8_SB(0, 0), cB, voffB); PG8_STAGE(PG8_SB(0, 1), cB + hstep, voffB); PG8_STAGE(PG8_SA(0, 0), cA, voffA); PG8_STAGE(PG8_SA(0, 1), cA + hstepA, voffA);
        if (wr == 1) PG8_BAR;
        PG8_WAIT_V(2); PG8_BAR;
        PG8_STAGE(PG8_SB(1, 0), cB + kstep, voffB); PG8_STAGE(PG8_SA(1, 0), cA + kstep, voffA); PG8_STAGE(PG8_SB(1, 1), cB + hstep + kstep, voffB);
        PG8_WAIT_V(6); PG8_BAR;
    } else {
        PG8_STAGE(PG8_SB(0, 0), cB, voffB); PG8_STAGE(PG8_SA(0, 0), cA, voffA); PG8_STAGE(PG8_SB(0, 1), cB + hstep, voffB); PG8_STAGE(PG8_SA(0, 1), cA + hstepA, voffA);
        if (wr == 1) PG8_BAR;
        PG8_WAIT_V(4); PG8_BAR;
        PG8_STAGE(PG8_SB(1, 0), cB + kstep, voffB); PG8_STAGE(PG8_SA(1, 0), cA + kstep, voffA); PG8_STAGE(PG8_SB(1, 1), cB + hstep + kstep, voffB);
        PG8_WAIT_V(6); PG8_BAR;
    }
    for (;;) {
        const bool has_next = S.next(ui + 1, nxt);
        const char* nA = has_next ? (const char*)g.A + (size_t)nxt.pm * tstepA + (size_t)nxt.k0 * (BK * 2) : cA; const char* nB = has_next ? (const char*)g.Bt + (size_t)nxt.pn * tstep + (size_t)nxt.k0 * (BK * 2) : cB;
        const int nt = cur.nk;
        for (int t = 0; t < nt; t += 2) {
            const bool last = (t == nt - 2);
            const char* a1 = cA + (size_t)(t + 1) * kstep;
            const char* a2 = last ? nA : cA + (size_t)(t + 2) * kstep; const char* b2 = last ? nB : cB + (size_t)(t + 2) * kstep;
            const char* a3 = a2 + kstep; const char* b3 = b2 + kstep;
            if (last && has_next) S.a_ready(nxt);
            if constexpr (SP2) {
            PG8_LDB(B0, 0, 0); PG8_LDB(B1, 0, 1); PG8_SCHED; PG8_LDA(At, 0, 0); PG8_STAGE(PG8_SA(1, 1), a1 + hstepA, voffA);
            PG8_WAIT_V(8); PG8_WAIT_L(0); PG8_BAR; PG8_MMA(0, 0, At, B0); PG8_MMA(0, 1, At, B1); PG8_BAR; PG8_SCHED;
            PG8_LDA(At, 0, 1); PG8_STAGE(PG8_SB(0, 0), b2, voffB); PG8_STAGE(PG8_SB(0, 1), b2 + hstep, voffB); PG8_STAGE(PG8_SA(0, 0), a2, voffA);
            PG8_WAIT_V(8); PG8_WAIT_L(0); PG8_BAR; PG8_MMA(1, 0, At, B0); PG8_MMA(1, 1, At, B1); PG8_BAR; PG8_SCHED;
            PG8_LDB(B0, 1, 0); PG8_LDB(B1, 1, 1); PG8_SCHED; PG8_LDA(At, 1, 0); PG8_STAGE(PG8_SA(0, 1), a2 + hstepA, voffA);
            PG8_WAIT_V(8); PG8_WAIT_L(0); PG8_BAR; PG8_MMA(0, 0, At, B0); PG8_MMA(0, 1, At, B1); PG8_BAR; PG8_SCHED;
            PG8_LDA(At, 1, 1); PG8_STAGE(PG8_SB(1, 0), b3, voffB); PG8_STAGE(PG8_SB(1, 1), b3 + hstep, voffB); PG8_STAGE(PG8_SA(1, 0), a3, voffA);
            PG8_WAIT_V(8); PG8_WAIT_L(0); PG8_BAR; PG8_MMA(1, 0, At, B0); PG8_MMA(1, 1, At, B1); PG8_BAR; PG8_SCHED;
            } else {
            PG8_LDB(B0, 0, 0); PG8_SCHED; PG8_LDA(At, 0, 0); PG8_STAGE(PG8_SA(1, 1), a1 + hstepA, voffA);
            PG8_WAIT_L(8); PG8_BAR; PG8_WAIT_L(0); PG8_MMA(0, 0, At, B0); PG8_BAR; PG8_SCHED;
            PG8_LDB(B1, 0, 1); PG8_STAGE(PG8_SB(0, 0), b2, voffB);
            PG8_BAR; PG8_WAIT_L(0); PG8_MMA(0, 1, At, B1); PG8_BAR;
            PG8_LDA(At, 0, 1); PG8_STAGE(PG8_SA(0, 0), a2, voffA);
            PG8_BAR; PG8_WAIT_L(0); PG8_MMA(1, 0, At, B0); PG8_BAR; PG8_SCHED;
            PG8_STAGE(PG8_SB(0, 1), b2 + hstep, voffB);
            PG8_WAIT_V(6); PG8_BAR; PG8_MMA(1, 1, At, B1); PG8_BAR;
            PG8_LDB(B0, 1, 0); PG8_SCHED; PG8_LDA(At, 1, 0); PG8_STAGE(PG8_SA(0, 1), a2 + hstepA, voffA);
            PG8_WAIT_L(8); PG8_BAR; PG8_WAIT_L(0); PG8_MMA(0, 0, At, B0); PG8_BAR; PG8_SCHED;
            PG8_LDB(B1, 1, 1); PG8_STAGE(PG8_SB(1, 0), b3, voffB);
            PG8_BAR; PG8_WAIT_L(0); PG8_MMA(0, 1, At, B1); PG8_BAR;
            PG8_LDA(At, 1, 1); PG8_STAGE(PG8_SA(1, 0), a3, voffA);
            PG8_BAR; PG8_WAIT_L(0); PG8_MMA(1, 0, At, B0); PG8_BAR; PG8_SCHED;
            PG8_STAGE(PG8_SB(1, 1), b3 + hstep, voffB);
            PG8_WAIT_V(6); PG8_BAR; PG8_MMA(1, 1, At, B1); PG8_BAR;
            }
        }
        if constexpr (ALIGN_EPI) { if (wr == 0) PG8_BAR; }
        if constexpr (!Epi::AFTER_DRAIN) { E(acc, cur, wr, wc, fr, fq); S.done(cur); }
        if (!has_next) break;
#pragma unroll
        for (int a = 0; a < 2; ++a)
#pragma unroll
            for (int b = 0; b < 2; ++b)
#pragma unroll
                for (int m = 0; m < 4; ++m)
#pragma unroll
                    for (int n = 0; n < 2; ++n) acc[a][b][m][n] = (f32x4){0.f, 0.f, 0.f, 0.f};
        cur = nxt; cA = nA; cB = nB; ++ui;
        if constexpr (ALIGN_EPI) { if (wr == 1) PG8_BAR; }
    }
    PG8_WAIT_V(0);
    if constexpr (!ALIGN_EPI) { if (wr == 0) PG8_BAR; }
    PG8_BAR;
    if constexpr (Epi::AFTER_DRAIN) { E.fused(acc, cur, wr, wc, fr, fq, lds, wid, lane); S.done(cur); }
#undef PG8_SA
#undef PG8_SB
#undef PG8_STAGE
#undef PG8_LDA
#undef PG8_LDB
#undef PG8_MMA
#undef PG8_WAIT_V
#undef PG8_WAIT_L
#undef PG8_BAR
#undef PG8_SCHED
}
}

using pg8::Unit;
__device__ __forceinline__ void st_bf16x8(bf16_t* p, const f32x4& v0, const f32x4& v1) {
    u32x4 w; w.x = cvt_pk_bf16(v0[0], v0[1]); w.y = cvt_pk_bf16(v0[2], v0[3]); w.z = cvt_pk_bf16(v1[0], v1[1]); w.w = cvt_pk_bf16(v1[2], v1[3]);
    *(u32x4*)p = w;
}

struct EpiABIn {
    static constexpr bool PERM = true, AFTER_DRAIN = false;
    bf16_t* qkv; bf16_t* vt; bf16_t* vtg; float* out_k; float* out_v; int jl;
    __device__ __forceinline__ void operator()(f32x4 (&acc)[2][2][4][2], const Unit& u, int wr, int wc, int fr, int fq) const {
#pragma unroll
        for (int bj = 0; bj < 2; ++bj) {
            const int cbase = u.pn * 256 + bj * 128 + wc * 32;
            if (cbase >= AB_IN) continue;
            const int c0 = cbase + 8 * fq;
#pragma unroll
            for (int ai = 0; ai < 2; ++ai)
#pragma unroll
                for (int m = 0; m < 4; ++m) {
                    const int r = u.pm * 256 + ai * 128 + wr * 64 + m * 16 + fr;
                    f32x4 v0 = acc[ai][bj][m][0], v1 = acc[ai][bj][m][1];
                    if (cbase < 512) { v0 = v0 * QSCALE; v1 = v1 * QSCALE; st_bf16x8(qkv + (size_t)r * QKVP_AB + c0, v0, v1); }
                    else if (cbase < 1024) {
                        st_bf16x8(qkv + (size_t)r * QKVP_AB + c0, v0, v1);
                        if (r < MP) { const int cc = c0 - 512; float* o = out_k + ((((size_t)(r >> 8) * 2 + jl) * 8 + (cc >> 6)) * 256 + (r & 255)) * 64 + (cc & 63); *(f32x4*)o = v0; *(f32x4*)(o + 4) = v1; }
                    } else if (cbase < 1536) {
                        const int cc = c0 - 1024, hh = cc >> 6, d = cc & 63;
                        bf16_t* dst; int T;
                        if (r < MP) { T = 256; dst = vt + ((size_t)((r >> 8) * 8 + hh) * 64 + d) * 256 + (r & 255);
                            float* o = out_v + ((((size_t)(r >> 8) * 2 + jl) * 8 + hh) * 256 + (r & 255)) * 64 + d; *(f32x4*)o = v0; *(f32x4*)(o + 4) = v1; }
                        else { const int rs = r - MP; T = 2048; dst = vt + (size_t)MP * 512 + ((size_t)((rs >> 11) * 8 + hh) * 64 + d) * 2048 + (rs & 2047); }
#pragma unroll
                        for (int i = 0; i < 4; ++i) { dst[(size_t)i * T] = f2bf1(v0[i]); dst[(size_t)(i + 4) * T] = f2bf1(v1[i]); }
                    } else if (cbase < 2048) { st_bf16x8(qkv + (size_t)r * QKVP_AB + c0 - 512, v0, v1); }
                    else if (cbase < 2560) {
                        const int cc = c0 - 2048, hh = cc >> 7, e = cc & 127;
                        bf16_t* dst; int T;
                        if (r < MP) { T = 256; dst = vtg + ((size_t)((r >> 8) * 4 + hh) * 128 + e) * 256 + (r & 255); }
                        else { const int rs = r - MP; T = 2048; dst = vtg + (size_t)MP * 512 + ((size_t)((rs >> 11) * 4 + hh) * 128 + e) * 2048 + (rs & 2047); }
#pragma unroll
                        for (int i = 0; i < 4; ++i) { dst[(size_t)i * T] = f2bf1(v0[i]); dst[(size_t)(i + 4) * T] = f2bf1(v1[i]); }
                    } else { st_bf16x8(qkv + (size_t)r * QKVP_AB + c0 - 1024, v0, v1); }
                }
        }
    }
};

struct EpiCIn {
    static constexpr bool PERM = true, AFTER_DRAIN = false;
    bf16_t* qkv; bf16_t* vt; float* out_k; float* out_v; const float* qn; const float* kn; const float* ropec; const float* ropes; int jl;
    __device__ __forceinline__ void operator()(f32x4 (&acc)[2][2][4][2], const Unit& u, int wr, int wc, int fr, int fq) const {
        const int pn = u.pn;
        const bool sample = u.pm >= 16;
        if (pn < 5) {
            const float* gw = pn < 4 ? qn : kn;
            f32x4 g[2][2];
#pragma unroll
            for (int bj = 0; bj < 2; ++bj)
#pragma unroll
                for (int n = 0; n < 2; ++n) g[bj][n] = *(const f32x4*)(gw + 32 * bj + 8 * fq + 4 * n);
#pragma unroll
            for (int ai = 0; ai < 2; ++ai)
#pragma unroll
                for (int m = 0; m < 4; ++m) {
                    const int r = u.pm * 256 + ai * 128 + wr * 64 + m * 16 + fr;
                    float ss = 0.f;
#pragma unroll
                    for (int bj = 0; bj < 2; ++bj)
#pragma unroll
                        for (int n = 0; n < 2; ++n) { const f32x4 x = acc[ai][bj][m][n]; ss += (x[0] * x[0] + x[1] * x[1]) + (x[2] * x[2] + x[3] * x[3]); }
                    ss += __shfl_xor(ss, 16); ss += __shfl_xor(ss, 32);
                    const float rstd = rsqrtf(ss * (1.0f / 64.0f) + EPS);
                    f32x4 v[2][2];
#pragma unroll
                    for (int bj = 0; bj < 2; ++bj)
#pragma unroll
                        for (int n = 0; n < 2; ++n) v[bj][n] = acc[ai][bj][m][n] * rstd * g[bj][n];
                    if (pn == 4 && !sample) {
#pragma unroll
                        for (int bj = 0; bj < 2; ++bj) { float* o = out_k + ((((size_t)(r >> 8) * 2 + jl) * 4 + wc) * 256 + (r & 255)) * 64 + 32 * bj + 8 * fq; *(f32x4*)o = v[bj][0]; *(f32x4*)(o + 4) = v[bj][1]; }
                    }
                    if (sample) {
                        const int t = (r - MP) & 2047;
#pragma unroll
                        for (int bj = 0; bj < 2; ++bj)
#pragma unroll
                            for (int n = 0; n < 2; ++n) {
                                const int f = 16 * bj + 8 * (fq & 1) + 4 * n;
                                const f32x4 cs = *(const f32x4*)(ropec + t * 32 + f), sn = *(const f32x4*)(ropes + t * 32 + f);
                                f32x4 pv;
#pragma unroll
                                for (int j = 0; j < 4; ++j) pv[j] = __shfl_xor(v[bj][n][j], 32);
                                if (fq < 2) v[bj][n] = v[bj][n] * cs - pv * sn; else v[bj][n] = v[bj][n] * cs + pv * sn;
                            }
                    }
                    if (pn < 4) {
#pragma unroll
                        for (int bj = 0; bj < 2; ++bj) st_bf16x8(qkv + (size_t)r * QKVP_C + (4 * pn + wc) * 64 + 32 * bj + 8 * fq, v[bj][0] * QSCALE, v[bj][1] * QSCALE);
                    } else {
#pragma unroll
                        for (int bj = 0; bj < 2; ++bj) st_bf16x8(qkv + (size_t)r * QKVP_C + 1024 + wc * 64 + 32 * bj + 8 * fq, v[bj][0], v[bj][1]);
                    }
                }
        } else {
#pragma unroll
            for (int ai = 0; ai < 2; ++ai)
#pragma unroll
                for (int m = 0; m < 4; ++m) {
                    const int r = u.pm * 256 + ai * 128 + wr * 64 + m * 16 + fr;
#pragma unroll
                    for (int bj = 0; bj < 2; ++bj) {
                        const int d = 32 * bj + 8 * fq;
                        const f32x4 v0 = acc[ai][bj][m][0], v1 = acc[ai][bj][m][1];
                        bf16_t* dst; int T;
                        if (!sample) { T = 256; dst = vt + ((size_t)((r >> 8) * 4 + wc) * 64 + d) * 256 + (r & 255);
                            float* o = out_v + ((((size_t)(r >> 8) * 2 + jl) * 4 + wc) * 256 + (r & 255)) * 64 + d; *(f32x4*)o = v0; *(f32x4*)(o + 4) = v1; }
                        else { const int rs = r - MP; T = 2048; dst = vt + (size_t)MP * 256 + ((size_t)((rs >> 11) * 4 + wc) * 64 + d) * 2048 + (rs & 2047); }
#pragma unroll
                        for (int i = 0; i < 4; ++i) { dst[(size_t)i * T] = f2bf1(v0[i]); dst[(size_t)(i + 4) * T] = f2bf1(v1[i]); }
                    }
                }
        }
    }
};

struct EpiRes {
    static constexpr bool PERM = true, AFTER_DRAIN = false;
    float* x; const float* gate; bf16_t* pend;
    __device__ __forceinline__ void operator()(f32x4 (&acc)[2][2][4][2], const Unit& u, int wr, int wc, int fr, int fq) const {
#pragma unroll
        for (int ai = 0; ai < 2; ++ai)
#pragma unroll
            for (int m = 0; m < 4; ++m) {
                const int r = u.pm * 256 + ai * 128 + wr * 64 + m * 16 + fr;
                const float* gp = gate + (size_t)cond_of_row(r) * 6144;
#pragma unroll
                for (int bj = 0; bj < 2; ++bj) {
                    const int c0 = u.pn * 256 + bj * 128 + wc * 32 + 8 * fq;
                    float* xp = x + (size_t)r * DM + c0;
                    const f32x4 g0 = *(const f32x4*)(gp + c0), g1 = *(const f32x4*)(gp + c0 + 4);
                    if (u.part < 0) {
                        f32x4 x0 = *(f32x4*)xp, x1 = *(f32x4*)(xp + 4);
                        x0 = x0 + g0 * acc[ai][bj][m][0]; x1 = x1 + g1 * acc[ai][bj][m][1];
                        *(f32x4*)xp = x0; *(f32x4*)(xp + 4) = x1;
                    } else {
                        st_bf16x8(pend + ((size_t)u.part * 4096 + (r - 16384)) * DM + c0, g0 * acc[ai][bj][m][0], g1 * acc[ai][bj][m][1]);
                    }
                    __builtin_amdgcn_sched_barrier(0);
                }
            }
    }
};

struct OneUnit {
    Unit u;
    __device__ __forceinline__ bool next(int i, Unit& o) const { if (i) return false; o = u; return true; }
    __device__ __forceinline__ void a_ready(const Unit&) const {}
    __device__ __forceinline__ void done(const Unit&) const {}
};
constexpr int UP_PITCH = 528;
struct EpiUp {
    static constexpr bool PERM = true, AFTER_DRAIN = true;
    bf16_t* act; const float* cw; const float* cb;
    __device__ __forceinline__ void fused(f32x4 (&acc)[2][2][4][2], const Unit& u, int wr, int wc, int fr, int fq, LAS unsigned char* lds, int wid, int lane) const {
#pragma unroll
        for (int ai = 0; ai < 2; ++ai)
#pragma unroll
            for (int m = 0; m < 4; ++m)
#pragma unroll
                for (int bj = 0; bj < 2; ++bj) {
                    const f32x4 v0 = acc[ai][bj][m][0], v1 = acc[ai][bj][m][1];
                    u32x4 w; w.x = cvt_pk_bf16(v0[0], v0[1]); w.y = cvt_pk_bf16(v0[2], v0[3]); w.z = cvt_pk_bf16(v1[0], v1[1]); w.w = cvt_pk_bf16(v1[2], v1[3]);
                    *(LAS u32x4*)(lds + ((2 * ai + wr) * 64 + 16 * m + fr) * UP_PITCH + (bj * 128 + wc * 32 + 8 * fq) * 2) = w;
                }
        if (wid == 0 && lane < 33) *(LAS u32x4*)(lds + 256 * UP_PITCH + lane * 16) = (u32x4){0u, 0u, 0u, 0u};
        __syncthreads();
        const int tid = wid * 64 + lane, chunk = tid & 15;
        const int cval = u.pn * 128 + chunk * 8;
        f32x4 wv[3][2], wg[3][2], bv[2], bg[2];
#pragma unroll
        for (int h = 0; h < 2; ++h) {
#pragma unroll
            for (int t = 0; t < 3; ++t) { wv[t][h] = *(const f32x4*)(cw + t * 2 * DFF + cval + 4 * h); wg[t][h] = *(const f32x4*)(cw + t * 2 * DFF + DFF + cval + 4 * h); }
            bv[h] = *(const f32x4*)(cb + cval + 4 * h); bg[h] = *(const f32x4*)(cb + DFF + cval + 4 * h);
        }
        for (int i = 0; i < 8; ++i) {
            const int row = (tid >> 4) + 32 * i;
            const int R = u.pm * 254 - 1 + row;
            if (row < 1 || row > 254 || R < 0 || R >= MALL) continue;
            int t, T; if (R < MP) { t = R & 255; T = 256; } else { t = (R - MP) & 2047; T = 2048; }
            const bool hl = t > 0, hr = t < T - 1;
            const LAS unsigned char* rp = lds + row * UP_PITCH + chunk * 16;
            const LAS unsigned char* zrow = lds + 256 * UP_PITCH;
            const LAS unsigned char* rpp = hl ? rp - UP_PITCH : zrow + chunk * 16;
            const LAS unsigned char* rpn = hr ? rp + UP_PITCH : zrow + chunk * 16;
            const u32x4 pv = *(const LAS u32x4*)rpp, cv = *(const LAS u32x4*)rp, nv = *(const LAS u32x4*)rpn;
            const u32x4 pg = *(const LAS u32x4*)(rpp + 256), cg_ = *(const LAS u32x4*)(rp + 256), ng = *(const LAS u32x4*)(rpn + 256);
            float o[8];
#pragma unroll
            for (int e = 0; e < 8; ++e) {
                const int h = e >> 2, j = e & 3;
                const unsigned wp = e < 2 ? pv.x : e < 4 ? pv.y : e < 6 ? pv.z : pv.w, wc_ = e < 2 ? cv.x : e < 4 ? cv.y : e < 6 ? cv.z : cv.w, wn = e < 2 ? nv.x : e < 4 ? nv.y : e < 6 ? nv.z : nv.w;
                const unsigned gp = e < 2 ? pg.x : e < 4 ? pg.y : e < 6 ? pg.z : pg.w, gc = e < 2 ? cg_.x : e < 4 ? cg_.y : e < 6 ? cg_.z : cg_.w, gn = e < 2 ? ng.x : e < 4 ? ng.y : e < 6 ? ng.z : ng.w;
                const float vp = (e & 1) ? bfhi(wp) : bflo(wp), vc = (e & 1) ? bfhi(wc_) : bflo(wc_), vn = (e & 1) ? bfhi(wn) : bflo(wn);
                const float qp = (e & 1) ? bfhi(gp) : bflo(gp), qc = (e & 1) ? bfhi(gc) : bflo(gc), qn = (e & 1) ? bfhi(gn) : bflo(gn);
                const float val = wv[0][h][j] * vp + wv[1][h][j] * vc + wv[2][h][j] * vn + bv[h][j];
                const float gat = wg[0][h][j] * qp + wg[1][h][j] * qc + wg[2][h][j] * qn + bg[h][j];
                o[e] = silu_f(gat) * val;
            }
            u32x4 w; w.x = cvt_pk_bf16(o[0], o[1]); w.y = cvt_pk_bf16(o[2], o[3]); w.z = cvt_pk_bf16(o[4], o[5]); w.w = cvt_pk_bf16(o[6], o[7]);
            *(u32x4*)(act + (size_t)R * DFF + cval) = w;
        }
        __syncthreads();
    }
};

#define MFMA16(a, b, c) __builtin_amdgcn_mfma_f32_16x16x32_bf16((a), (b), (c), 0, 0, 0)
constexpr int AT_KB = 0, AT_VB = 36864, AT_BIAS = 73728;

#define MASKED_SKIP(g) false
template <bool MASKED, class TileFn, class RowFn, class ActiveFn>
__device__ __forceinline__ void flash_unit(LAS unsigned char* lds, int nkt, TileFn tile, RowFn keyrow, ActiveFn active, bool wave_on,
                                           const bf16_t* q0, size_t qstride16, bf16_t* o0, size_t ostride16, int qrow) {
    const int tid = opaque_tid(), lane = tid & 63, fr = lane & 15, fq = lane >> 4;
    bf16x8 qf[4][2];
#pragma unroll
    for (int g = 0; g < 4; ++g) { qf[g][0] = *(const bf16x8*)(q0 + g * qstride16 + fq * 8); qf[g][1] = *(const bf16x8*)(q0 + g * qstride16 + 32 + fq * 8); }
    f32x4 o[4][4], lacc[4];
    f32x4 negm[4];
    bool fresh = true;
    bf16x8 ones;
#pragma unroll
    for (int i = 0; i < 8; ++i) ones[i] = (short)0x3F80;
#pragma unroll
    for (int g = 0; g < 4; ++g) { negm[g] = (f32x4){0.f, 0.f, 0.f, 0.f}; lacc[g] = (f32x4){0.f, 0.f, 0.f, 0.f};
#pragma unroll
        for (int a = 0; a < 4; ++a) o[a][g] = (f32x4){0.f, 0.f, 0.f, 0.f}; }
    const int srow = tid >> 3, sc = tid & 7;
    u32x4 kreg[1], vreg[1];
    auto gload = [&](int kt, int r) { const bf16_t* kp; const bf16_t* vp; int kpi, vpi; tile(kt, kp, kpi, vp, vpi);
        kreg[r] = *(const u32x4*)(kp + (size_t)srow * kpi + sc * 8); vreg[r] = *(const u32x4*)(vp + (size_t)srow * vpi + sc * 8); };
    auto sstore = [&](int kt, int r) { *(LAS u32x4*)(lds + AT_KB + (kt & 3) * 9216 + srow * 144 + sc * 16) = kreg[r]; *(LAS u32x4*)(lds + AT_VB + (kt & 3) * 9216 + srow * 144 + sc * 16) = vreg[r]; };
    gload(0, 0); sstore(0, 0);
    if (nkt > 1) { gload(1, 0); sstore(1, 0); }
    __syncthreads();
    const LAS float* bias = (const LAS float*)(lds + AT_BIAS);
    unsigned dcp[2][2][4];
    if (MASKED) {
#pragma unroll
        for (int hk = 0; hk < 2; ++hk)
#pragma unroll
            for (int tl = 0; tl < 2; ++tl)
#pragma unroll
                for (int g = 0; g < 4; ++g) {
                    const int qc = 16 * g + fr, cs = min(max(qc - 8, 0), 48);
                    unsigned pk = 0;
#pragma unroll
                    for (int j = 0; j < 4; ++j) {
                        const int kc = 32 * hk + 16 * tl + 4 * fq + j;
                        const bool ok = (kc >= cs) && (kc < cs + 16);
                        const int dc = ok ? min(max(kc - qc + 15, 0), 30) : 31;
                        pk |= (unsigned)(dc * 4) << (8 * j);
                    }
                    dcp[hk][tl][g] = pk;
                }
    }
    auto tile_compute = [&](int kt) {
        if (wave_on && active(kt)) {
            const int buf = kt & 3;
            const LAS unsigned char* Kb = lds + AT_KB + buf * 9216; const LAS unsigned char* Vb = lds + AT_VB + buf * 9216;
            const int kr = MASKED ? keyrow(kt) : -1;
            auto qk = [&](int hk, f32x4 (&sd)[2][4]) {
#pragma unroll
                for (int tl = 0; tl < 2; ++tl) {
                    const bf16x8 kf0 = *(const LAS bf16x8*)(Kb + ((2 * hk + tl) * 16 + fr) * 144 + fq * 16);
                    const bf16x8 kf1 = *(const LAS bf16x8*)(Kb + ((2 * hk + tl) * 16 + fr) * 144 + 64 + fq * 16);
#pragma unroll
                    for (int g = 0; g < 4; ++g) sd[tl][g] = MFMA16(kf0, qf[g][0], negm[g]);
#pragma unroll
                    for (int g = 0; g < 4; ++g) sd[tl][g] = MFMA16(kf1, qf[g][1], sd[tl][g]);
                }
            };
            auto half_body = [&](int hk, f32x4 (&s)[2][4], f32x4 (*other)[4]) {
                if (MASKED) {
                    if (kr >= 0) {
                        const LAS unsigned char* brow = (const LAS unsigned char*)(bias + (kr - qrow + 7) * 32);
#pragma unroll
                        for (int g = 0; g < 4; ++g)
#pragma unroll
                            for (int tl = 0; tl < 2; ++tl) {
                                const unsigned pk = hk ? dcp[1][tl][g] : dcp[0][tl][g];
#pragma unroll
                                for (int j = 0; j < 4; ++j) s[tl][g][j] += *(const LAS float*)(brow + ((pk >> (8 * j)) & 0xffu));
                            }
                    }
                }
                bool need = fresh;
#pragma unroll
                for (int g = 0; g < 4; ++g) {
                    if (MASKED_SKIP(g)) continue;
                    typedef int i32x4 __attribute__((ext_vector_type(4)));
                    const i32x4 a = __builtin_bit_cast(i32x4, s[0][g]), b = __builtin_bit_cast(i32x4, s[1][g]);
                    const int m1 = max(max(a[0], a[1]), a[2]), m2 = max(max(a[3], b[0]), b[1]), m3 = max(max(b[2], b[3]), m1);
                    need = need || (max(m2, m3) > 0x41000000);
                }
                if (__any(need)) {
#pragma unroll
                    for (int g = 0; g < 4; ++g) {
                        if (MASKED_SKIP(g)) continue;
                        const f32x4 m4 = __builtin_elementwise_max(s[0][g], s[1][g]);
                        float r = fmaxf(fmaxf(m4[0], m4[1]), fmaxf(m4[2], m4[3])); r = fmaxf(r, __shfl_xor(r, 16)); r = fmaxf(r, __shfl_xor(r, 32));
                        const float rr = fresh ? r : fmaxf(r, 0.0f);
                        const float alpha = fresh ? 0.0f : __builtin_amdgcn_exp2f(-rr);
                        negm[g] = negm[g] - rr; lacc[g] = lacc[g] * alpha;
                        s[0][g] = s[0][g] - rr; s[1][g] = s[1][g] - rr;
                        if (other) { other[0][g] = other[0][g] - rr; other[1][g] = other[1][g] - rr; }
#pragma unroll
                        for (int a = 0; a < 4; ++a) o[a][g] = o[a][g] * alpha;
                    }
                }
                fresh = false;
                bf16x8 pf[4];
#pragma unroll
                for (int g = 0; g < 4; ++g) {
#pragma unroll
                    for (int tl = 0; tl < 2; ++tl) {
                        f32x4 e = s[tl][g];
                        e[0] = __builtin_amdgcn_exp2f(e[0]); e[1] = __builtin_amdgcn_exp2f(e[1]); e[2] = __builtin_amdgcn_exp2f(e[2]); e[3] = __builtin_amdgcn_exp2f(e[3]);
                        s[tl][g] = e;
                    }
                    u32x4 w; w.x = cvt_pk_bf16(s[0][g][0], s[0][g][1]); w.y = cvt_pk_bf16(s[0][g][2], s[0][g][3]);
                    w.z = cvt_pk_bf16(s[1][g][0], s[1][g][1]); w.w = cvt_pk_bf16(s[1][g][2], s[1][g][3]);
                    pf[g] = __builtin_bit_cast(bf16x8, w);
                    lacc[g] = MFMA16(ones, pf[g], lacc[g]);
                }
#pragma unroll
                for (int dt = 0; dt < 4; ++dt) {
                    const LAS unsigned char* vp = Vb + (dt * 16 + fr) * 144 + hk * 64 + fq * 8;
                    const u32x2 lo = *(const LAS u32x2*)vp, hi = *(const LAS u32x2*)(vp + 32);
                    u32x4 w; w.x = lo.x; w.y = lo.y; w.z = hi.x; w.w = hi.y;
                    const bf16x8 vf = __builtin_bit_cast(bf16x8, w);
#pragma unroll
                    for (int g = 0; g < 4; ++g) o[dt][g] = MFMA16(vf, pf[g], o[dt][g]);
                }
            };
            if constexpr (MASKED) {
#pragma unroll 1
                for (int hk = 0; hk < 2; ++hk) { f32x4 s1[2][4]; qk(hk, s1); half_body(hk, s1, nullptr); }
            } else {
                f32x4 sb[2][2][4];
                qk(0, sb[0]); qk(1, sb[1]);
                __builtin_amdgcn_sched_barrier(0);
                half_body(0, sb[0], sb[1]);
                __builtin_amdgcn_sched_barrier(0);
                half_body(1, sb[1], nullptr);
                __builtin_amdgcn_sched_barrier(0);
            }
        }
    };
    for (int kt = 0; kt < nkt; ++kt) {
        if (kt + 2 < nkt) gload(kt + 2, 0);
        tile_compute(kt);
        if (kt + 2 < nkt) sstore(kt + 2, 0);
        if (kt & 1) __syncthreads();
    }
    if (nkt & 1) __syncthreads();
    if (wave_on) {
#pragma unroll
        for (int g = 0; g < 4; ++g) {
            const float inv = 1.0f / lacc[g][0];
            bf16_t* op = o0 + g * ostride16;
#pragma unroll
            for (int dt = 0; dt < 4; ++dt) {
                u32x2 w; w.x = cvt_pk_bf16(o[dt][g][0] * inv, o[dt][g][1] * inv); w.y = cvt_pk_bf16(o[dt][g][2] * inv, o[dt][g][3] * inv);
                *(u32x2*)(op + dt * 16 + 4 * fq) = w;
            }
        }
    }
}

constexpr int GL_QF = 0, GL_QB = 9216, GL_KF = 18432, GL_KB = 27648, GL_VT = 36864, GL_SF = 55296, GL_SB = 73728, GL_OB = 92160, GL_GT = 125952, GL_BM = 130048, GL_LR = 130560;

__device__ __forceinline__ void gla_chunk_geom(int gc, int hh, int& T, size_t& vbase) {
    if (gc < 64) { T = 256; vbase = ((size_t)((gc >> 2) * 4 + hh) * 128) * 256 + (gc & 3) * 64; }
    else { const int s = gc - 64; T = 2048; vbase = (size_t)MP * 512 + ((size_t)((s >> 5) * 4 + hh) * 128) * 2048 + (s & 31) * 64; }
}
__device__ __forceinline__ void gla_load_w(const float* w2, const float* b2, int hh, int d, float (&w)[16], float& bias) {
#pragma unroll
    for (int r = 0; r < 16; ++r) w[r] = w2[r * 256 + hh * 64 + d];
    bias = b2[hh * 64 + d];
}
__device__ __forceinline__ void gla_gates(const LAS unsigned char* lrs, const float (&w)[16], float bias, int ig, int dir, float (&g)[8]) {
#pragma unroll
    for (int i = 0; i < 8; ++i) {
        const LAS u32x4* row = (const LAS u32x4*)(lrs + (ig * 8 + i) * 64 + dir * 32);
        const u32x4 a = row[0], b = row[1];
        float x = bias;
        x += w[0] * bflo(a.x) + w[1] * bfhi(a.x) + w[2] * bflo(a.y) + w[3] * bfhi(a.y) + w[4] * bflo(a.z) + w[5] * bfhi(a.z) + w[6] * bflo(a.w) + w[7] * bfhi(a.w);
        x += w[8] * bflo(b.x) + w[9] * bfhi(b.x) + w[10] * bflo(b.y) + w[11] * bfhi(b.y) + w[12] * bflo(b.z) + w[13] * bfhi(b.z) + w[14] * bflo(b.w) + w[15] * bfhi(b.w);
        const float ls = fminf(x, 0.f) - __logf(1.0f + __expf(-fabsf(x)));
        g[i] = ls * (1.0f / 16.0f);
    }
}

__device__ __forceinline__ void gla_stepA(const Params& p, LAS unsigned char* lds, int unit, int jl) {
    const int tid = opaque_tid(), lane = tid & 63, w = tid >> 6, fr = lane & 15, fq = lane >> 4;
    const int gc = unit >> 2, hh = unit & 3, m0 = gc * 64;
    const bf16_t* qkv = (const bf16_t*)(p.ws + OFF_QKV); const bf16_t* vtg = (const bf16_t*)(p.ws + OFF_VTG);
    bf16_t* gst = (bf16_t*)(p.ws + OFF_GST); float* gam = (float*)(p.ws + OFF_GAM);
    int T; size_t vbase; gla_chunk_geom(gc, hh, T, vbase);
    const int d = tid & 63, ig = tid >> 6;
    u32x4 lr_reg = (u32x4){0u, 0u, 0u, 0u}, vt_reg[2];
    if (tid < 256) lr_reg = *(const u32x4*)(qkv + (size_t)(m0 + (tid >> 2)) * QKVP_AB + 2048 + (tid & 3) * 8);
#pragma unroll
    for (int it = 0; it < 2; ++it) { const int idx = tid + it * 512, e = idx >> 3, pc = idx & 7; vt_reg[it] = *(const u32x4*)(vtg + vbase + (size_t)e * T + pc * 8); }
    float wf[16], wb[16], biasf, biasb;
    gla_load_w(p.w2f + jl * 4096, p.b2f + jl * 256, hh, d, wf, biasf);
    gla_load_w(p.w2b + jl * 4096, p.b2b + jl * 256, hh, d, wb, biasb);
    unsigned short kraw[8];
#pragma unroll
    for (int i = 0; i < 8; ++i) kraw[i] = qkv[(size_t)(m0 + ig * 8 + i) * QKVP_AB + 1280 + hh * 64 + d];
    if (tid < 256) *(LAS u32x4*)(lds + GL_LR + (tid >> 2) * 64 + (tid & 3) * 16) = lr_reg;
#pragma unroll
    for (int it = 0; it < 2; ++it) { const int idx = tid + it * 512, e = idx >> 3, pc = idx & 7; *(LAS u32x4*)(lds + GL_VT + e * 144 + pc * 16) = vt_reg[it]; }
    __syncthreads();
    float g[2][8];
    gla_gates(lds + GL_LR, wf, biasf, ig, 0, g[0]);
    gla_gates(lds + GL_LR, wb, biasb, ig, 1, g[1]);
    LAS float* gt = (LAS float*)(lds + GL_GT);
#pragma unroll
    for (int dir = 0; dir < 2; ++dir) { float run = 0.f;
#pragma unroll
        for (int i = 0; i < 8; ++i) { run += g[dir][i]; g[dir][i] = run; }
        gt[(dir * 8 + ig) * 64 + d] = run; }
    __syncthreads();
    float kv[8];
#pragma unroll
    for (int i = 0; i < 8; ++i) kv[i] = bf2f(kraw[i]);
#pragma unroll
    for (int dir = 0; dir < 2; ++dir) {
        float off = 0.f, tot = 0.f;
#pragma unroll
        for (int q = 0; q < 8; ++q) { const float t = gt[(dir * 8 + q) * 64 + d]; tot += t; off += (q < ig) ? t : 0.f; }
        float dec[8];
#pragma unroll
        for (int i = 0; i < 8; ++i) {
            const float incl = off + g[dir][i];
            const float excl = off + (i > 0 ? g[dir][i > 0 ? i - 1 : 0] : 0.f);
            dec[i] = kv[i] * __expf(dir == 0 ? (tot - incl) : excl);
        }
        u32x4 wv; wv.x = cvt_pk_bf16(dec[0], dec[1]); wv.y = cvt_pk_bf16(dec[2], dec[3]); wv.z = cvt_pk_bf16(dec[4], dec[5]); wv.w = cvt_pk_bf16(dec[6], dec[7]);
        *(LAS u32x4*)(lds + (dir ? GL_KB : GL_KF) + d * 144 + ig * 16) = wv;
        if (ig == 0) gam[(size_t)((gc * 4 + hh) * 2 + dir) * 64 + d] = __expf(tot);
    }
    __syncthreads();
    bf16x8 vf[2];
#pragma unroll
    for (int ks = 0; ks < 2; ++ks) vf[ks] = *(const LAS bf16x8*)(lds + GL_VT + (w * 16 + fr) * 144 + ks * 64 + fq * 16);
#pragma unroll
    for (int dir = 0; dir < 2; ++dir) {
        bf16_t* dst = gst + (size_t)((gc * 4 + hh) * 2 + dir) * 8192;
#pragma unroll
        for (int dkt = 0; dkt < 4; ++dkt) {
            f32x4 a = (f32x4){0.f, 0.f, 0.f, 0.f};
#pragma unroll
            for (int ks = 0; ks < 2; ++ks) { const bf16x8 kf = *(const LAS bf16x8*)(lds + (dir ? GL_KB : GL_KF) + (dkt * 16 + fr) * 144 + ks * 64 + fq * 16); a = MFMA16(kf, vf[ks], a); }
            u32x2 o; o.x = cvt_pk_bf16(a[0], a[1]); o.y = cvt_pk_bf16(a[2], a[3]);
            *(u32x2*)(dst + (w * 16 + fr) * 64 + dkt * 16 + 4 * fq) = o;
        }
    }
    __syncthreads();
}

__device__ __forceinline__ void gla_stepB(const Params& p, int jl) {
    bf16_t* gst = (bf16_t*)(p.ws + OFF_GST); const float* gam = (const float*)(p.ws + OFF_GAM);
    const int gtid = blockIdx.x * 512 + opaque_tid(), gn = gridDim.x * 512;
    for (int item = gtid; item < 192 * 1024; item += gn) {
        const int combo = item >> 10, piece = item & 1023, dv = piece >> 3, dk0 = (piece & 7) * 8;
        const int dir = combo & 1, hh = (combo >> 1) & 3, sq = combo >> 3;
        const int nc = sq < 16 ? 4 : 32, gc0 = sq < 16 ? sq * 4 : 64 + (sq - 16) * 32;
        float S[8];
        if (sq < 16) {
#pragma unroll
            for (int i = 0; i < 8; ++i) S[i] = 0.f;
        } else {
            const float* s0 = (dir ? p.st_b : p.st_f) + ((size_t)((sq - 16) * 2 + jl) * 4 + hh) * 8192;
#pragma unroll
            for (int i = 0; i < 8; ++i) S[i] = s0[(dk0 + i) * 128 + dv];
        }
        for (int pb = 0; pb < nc; pb += 4) {
            u32x4 dl[4]; f32x4 g0[4], g1[4]; bf16_t* sp[4];
#pragma unroll
            for (int u = 0; u < 4; ++u) {
                const int pp = pb + u, c = dir ? nc - 1 - pp : pp;
                const size_t slot = (size_t)((gc0 + c) * 4 + hh) * 2 + dir;
                sp[u] = gst + slot * 8192 + dv * 64 + dk0;
                dl[u] = *(const u32x4*)sp[u];
                g0[u] = *(const f32x4*)(gam + slot * 64 + dk0); g1[u] = *(const f32x4*)(gam + slot * 64 + dk0 + 4);
            }
#pragma unroll
            for (int u = 0; u < 4; ++u) {
                u32x4 o; o.x = cvt_pk_bf16(S[0], S[1]); o.y = cvt_pk_bf16(S[2], S[3]); o.z = cvt_pk_bf16(S[4], S[5]); o.w = cvt_pk_bf16(S[6], S[7]);
                *(u32x4*)sp[u] = o;
                S[0] = g0[u][0] * S[0] + bflo(dl[u].x); S[1] = g0[u][1] * S[1] + bfhi(dl[u].x); S[2] = g0[u][2] * S[2] + bflo(dl[u].y); S[3] = g0[u][3] * S[3] + bfhi(dl[u].y);
                S[4] = g1[u][0] * S[4] + bflo(dl[u].z); S[5] = g1[u][1] * S[5] + bfhi(dl[u].z); S[6] = g1[u][2] * S[6] + bflo(dl[u].w); S[7] = g1[u][3] * S[7] + bfhi(dl[u].w);
            }
        }
        if (sq < 16) {
            float* o = p.out + (dir ? OUT_GB : OUT_GF) + ((size_t)(sq * 2 + jl) * 4 + hh) * 8192;
#pragma unroll
            for (int i = 0; i < 8; ++i) o[(dk0 + i) * 128 + dv] = S[i];
        }
    }
}

__device__ __forceinline__ void gla_stepC(const Params& p, LAS unsigned char* lds, int unit, int jl) {
    const int tid = opaque_tid(), lane = tid & 63, w = tid >> 6, fr = lane & 15, fq = lane >> 4;
    const int gc = unit >> 2, hh = unit & 3, m0 = gc * 64;
    const bf16_t* qkv = (const bf16_t*)(p.ws + OFF_QKV); const bf16_t* vtg = (const bf16_t*)(p.ws + OFF_VTG);
    const bf16_t* gst = (const bf16_t*)(p.ws + OFF_GST); bf16_t* O = (bf16_t*)(p.ws + OFF_O);
    int T; size_t vbase; gla_chunk_geom(gc, hh, T, vbase);
    const int d = tid & 63, ig = tid >> 6;
    u32x4 lr_reg = (u32x4){0u, 0u, 0u, 0u}, vt_reg[2];
    if (tid < 256) lr_reg = *(const u32x4*)(qkv + (size_t)(m0 + (tid >> 2)) * QKVP_AB + 2048 + (tid & 3) * 8);
#pragma unroll
    for (int it = 0; it < 2; ++it) { const int idx = tid + it * 512, e = idx >> 3, pc = idx & 7; vt_reg[it] = *(const u32x4*)(vtg + vbase + (size_t)e * T + pc * 8); }
    float wf[16], wb[16], biasf, biasb;
    gla_load_w(p.w2f + jl * 4096, p.b2f + jl * 256, hh, d, wf, biasf);
    gla_load_w(p.w2b + jl * 4096, p.b2b + jl * 256, hh, d, wb, biasb);
    unsigned short qraw[8], kraw[8];
#pragma unroll
    for (int i = 0; i < 8; ++i) { const bf16_t* rp = qkv + (size_t)(m0 + ig * 8 + i) * QKVP_AB + hh * 64 + d; qraw[i] = rp[1024]; kraw[i] = rp[1280]; }
    if (tid < 256) *(LAS u32x4*)(lds + GL_LR + (tid >> 2) * 64 + (tid & 3) * 16) = lr_reg;
#pragma unroll
    for (int it = 0; it < 2; ++it) { const int idx = tid + it * 512, e = idx >> 3, pc = idx & 7; *(LAS u32x4*)(lds + GL_VT + e * 144 + pc * 16) = vt_reg[it]; }
    __syncthreads();
    float g[2][8], gi[2][8];
    gla_gates(lds + GL_LR, wf, biasf, ig, 0, g[0]);
    gla_gates(lds + GL_LR, wb, biasb, ig, 1, g[1]);
    LAS float* gt = (LAS float*)(lds + GL_GT);
#pragma unroll
    for (int dir = 0; dir < 2; ++dir) { float run = 0.f;
#pragma unroll
        for (int i = 0; i < 8; ++i) { gi[dir][i] = g[dir][i]; run += g[dir][i]; g[dir][i] = run; }
        gt[(dir * 8 + ig) * 64 + d] = run; }
    __syncthreads();
    float qv[8], kv[8];
#pragma unroll
    for (int i = 0; i < 8; ++i) { qv[i] = bf2f(qraw[i]) * 0.125f; kv[i] = bf2f(kraw[i]); }
#pragma unroll
    for (int dir = 0; dir < 2; ++dir) {
        float off = 0.f, tot = 0.f, lo4 = 0.f;
#pragma unroll
        for (int q = 0; q < 8; ++q) { const float t = gt[(dir * 8 + q) * 64 + d]; tot += t; off += (q < ig) ? t : 0.f; lo4 += (q < 4) ? t : 0.f; }
        const float bmid = dir == 0 ? lo4 : (tot - lo4);
        LAS unsigned char* Qd = lds + (dir ? GL_QB : GL_QF); LAS unsigned char* Kd = lds + (dir ? GL_KB : GL_KF);
#pragma unroll
        for (int i = 0; i < 8; ++i) {
            const float b = dir == 0 ? (off + g[dir][i]) : (tot - (off + g[dir][i] - gi[dir][i]));
            const float e = b - bmid;
            const int tok = ig * 8 + i;
            *(LAS unsigned short*)(Qd + tok * 144 + d * 2) = f2bf1(qv[i] * __expf(e));
            *(LAS unsigned short*)(Kd + tok * 144 + d * 2) = f2bf1(kv[i] * __expf(-e));
        }
        if (ig == 0) ((LAS float*)(lds + GL_BM))[dir * 64 + d] = __expf(bmid);
    }
    __syncthreads();
#pragma unroll
    for (int dir = 0; dir < 2; ++dir) {
        const bf16_t* src = gst + (size_t)((gc * 4 + hh) * 2 + dir) * 8192;
        const LAS float* bm = (const LAS float*)(lds + GL_BM) + dir * 64;
#pragma unroll
        for (int it = 0; it < 2; ++it) {
            const int idx = tid + it * 512, dv = idx >> 3, pc = idx & 7;
            const u32x4 s = *(const u32x4*)(src + dv * 64 + pc * 8);
            const f32x4 e0 = *(const LAS f32x4*)(bm + pc * 8), e1 = *(const LAS f32x4*)(bm + pc * 8 + 4);
            u32x4 o; o.x = cvt_pk_bf16(bflo(s.x) * e0[0], bfhi(s.x) * e0[1]); o.y = cvt_pk_bf16(bflo(s.y) * e0[2], bfhi(s.y) * e0[3]);
            o.z = cvt_pk_bf16(bflo(s.z) * e1[0], bfhi(s.z) * e1[1]); o.w = cvt_pk_bf16(bflo(s.w) * e1[2], bfhi(s.w) * e1[3]);
            *(LAS u32x4*)(lds + (dir ? GL_SB : GL_SF) + dv * 144 + pc * 16) = o;
        }
    }
    __syncthreads();
    {
        const int dir = w >> 2, it = w & 3;
        const LAS unsigned char* Qd = lds + (dir ? GL_QB : GL_QF); const LAS unsigned char* Kd = lds + (dir ? GL_KB : GL_KF); const LAS unsigned char* Sd = lds + (dir ? GL_SB : GL_SF);
        bf16x8 qB[2];
#pragma unroll
        for (int ks = 0; ks < 2; ++ks) qB[ks] = *(const LAS bf16x8*)(Qd + (it * 16 + fr) * 144 + ks * 64 + fq * 16);
        f32x4 st[4];
        const int iq = 16 * it + fr;
#pragma unroll
        for (int jt = 0; jt < 4; ++jt) {
            st[jt] = (f32x4){0.f, 0.f, 0.f, 0.f};
#pragma unroll
            for (int ks = 0; ks < 2; ++ks) { const bf16x8 kf = *(const LAS bf16x8*)(Kd + (jt * 16 + fr) * 144 + ks * 64 + fq * 16); st[jt] = MFMA16(kf, qB[ks], st[jt]); }
#pragma unroll
            for (int j = 0; j < 4; ++j) { const int jj = 16 * jt + 4 * fq + j; const bool keep = dir == 0 ? (jj <= iq) : (jj >= iq); st[jt][j] = keep ? st[jt][j] : 0.f; }
        }
        bf16x8 pf[2];
#pragma unroll
        for (int kk = 0; kk < 2; ++kk) {
            u32x4 wv; wv.x = cvt_pk_bf16(st[2 * kk][0], st[2 * kk][1]); wv.y = cvt_pk_bf16(st[2 * kk][2], st[2 * kk][3]);
            wv.z = cvt_pk_bf16(st[2 * kk + 1][0], st[2 * kk + 1][1]); wv.w = cvt_pk_bf16(st[2 * kk + 1][2], st[2 * kk + 1][3]);
            pf[kk] = __builtin_bit_cast(bf16x8, wv);
        }
        f32x4 o[8];
#pragma unroll
        for (int dvt = 0; dvt < 8; ++dvt) {
            o[dvt] = (f32x4){0.f, 0.f, 0.f, 0.f};
#pragma unroll
            for (int kk = 0; kk < 2; ++kk) {
                const LAS unsigned char* vp = lds + GL_VT + (dvt * 16 + fr) * 144 + kk * 64 + fq * 8;
                const u32x2 lo = *(const LAS u32x2*)vp, hi = *(const LAS u32x2*)(vp + 32);
                u32x4 wv; wv.x = lo.x; wv.y = lo.y; wv.z = hi.x; wv.w = hi.y;
                o[dvt] = MFMA16(__builtin_bit_cast(bf16x8, wv), pf[kk], o[dvt]);
            }
#pragma unroll
            for (int ks = 0; ks < 2; ++ks) { const bf16x8 sf = *(const LAS bf16x8*)(Sd + (dvt * 16 + fr) * 144 + ks * 64 + fq * 16); o[dvt] = MFMA16(sf, qB[ks], o[dvt]); }
        }
        LAS float* ob = (LAS float*)(lds + GL_OB) + (it * 16 + fr) * 132;
        if (dir == 1) {
#pragma unroll
            for (int dvt = 0; dvt < 8; ++dvt) *(LAS f32x4*)(ob + dvt * 16 + 4 * fq) = o[dvt];
        }
        __syncthreads();
        if (dir == 0) {
            float ss = 0.f;
#pragma unroll
            for (int dvt = 0; dvt < 8; ++dvt) { o[dvt] = o[dvt] + *(const LAS f32x4*)(ob + dvt * 16 + 4 * fq); ss += (o[dvt][0] * o[dvt][0] + o[dvt][1] * o[dvt][1]) + (o[dvt][2] * o[dvt][2] + o[dvt][3] * o[dvt][3]); }
            ss += __shfl_xor(ss, 16); ss += __shfl_xor(ss, 32);
            const float rstd = rsqrtf(ss * (1.0f / 128.0f) + EPS);
            const int m = m0 + it * 16 + fr;
            const float* gn = p.gla_norm_g + jl * 512 + hh * 128;
#pragma unroll
            for (int dvt = 0; dvt < 8; ++dvt) {
                const int col = dvt * 16 + 4 * fq;
                const f32x4 gw = *(const f32x4*)(gn + col);
                const u32x2 rg = *(const u32x2*)(qkv + (size_t)m * QKVP_AB + 1536 + hh * 128 + col);
                const float y0 = o[dvt][0] * rstd * gw[0] * silu_f(bflo(rg.x)), y1 = o[dvt][1] * rstd * gw[1] * silu_f(bfhi(rg.x));
                const float y2 = o[dvt][2] * rstd * gw[2] * silu_f(bflo(rg.y)), y3 = o[dvt][3] * rstd * gw[3] * silu_f(bfhi(rg.y));
                u32x2 wv; wv.x = cvt_pk_bf16(y0, y1); wv.y = cvt_pk_bf16(y2, y3);
                *(u32x2*)(O + (size_t)m * DM + 512 + hh * 128 + col) = wv;
            }
        }
    }
    __syncthreads();
}

struct TItem { const float* W; bf16_t* WT; int K, N, k0, n0, drow0; };
__device__ __forceinline__ void titem_load(const TItem& t, float (&tv)[32], int lane) {
#pragma unroll
    for (int i = 0; i < 32; ++i) { const int kk = 2 * i + (lane >> 5); tv[i] = t.W[(size_t)(t.k0 + kk) * t.N + t.n0 + (lane & 31)]; }
}
__device__ __forceinline__ void titem_write(const TItem& t, const float (&tv)[32], LAS float* scr, int lane) {
#pragma unroll
    for (int i = 0; i < 32; ++i) { const int kk = 2 * i + (lane >> 5); scr[kk * 33 + (lane & 31)] = tv[i]; }
    asm volatile("s_waitcnt lgkmcnt(0)" ::: "memory");
    const int c = lane & 7;
#pragma unroll
    for (int j = 0; j < 4; ++j) { const int n = (lane >> 3) + 8 * j; const LAS float* s = scr + (8 * c) * 33 + n;
        u32x4 o; o.x = cvt_pk_bf16(s[0 * 33], s[1 * 33]); o.y = cvt_pk_bf16(s[2 * 33], s[3 * 33]); o.z = cvt_pk_bf16(s[4 * 33], s[5 * 33]); o.w = cvt_pk_bf16(s[6 * 33], s[7 * 33]);
        *(u32x4*)(t.WT + (size_t)(t.drow0 + n) * t.K + t.k0 + 8 * c) = o; }
    asm volatile("s_waitcnt lgkmcnt(0)" ::: "memory");
}

__device__ __forceinline__ void prologue(const Params& p, LAS unsigned char* lds) {
    const int tid = opaque_tid(), lane = tid & 63, w = tid >> 6;
    {
        LAS float* scr = (LAS float*)(lds + w * 16384);
        const int gw = blockIdx.x * 8 + w, NGW = gridDim.x * 8;
        constexpr int I_ABIN = 16 * 97, I_SQ = 16 * 32, I_CIN = 16 * 48, I_UP = 16 * 176, I_DN = 44 * 32;
        constexpr int N_ABIN = 2 * I_ABIN, N_ABOUT = 2 * I_SQ, N_CIN = 2 * I_CIN, N_COUT = 2 * I_SQ, N_UP = 4 * I_UP, N_DN = 4 * I_DN;
        constexpr int NITEMS = N_ABIN + N_ABOUT + N_CIN + N_COUT + N_UP + N_DN;
        auto decode = [&](int it, TItem& t) {
            int r = it;
            if (r < N_ABIN) { const int l = r / I_ABIN, q = r % I_ABIN, kb = q / 97, nb = q % 97;
                t = TItem{p.ab_w_in + (size_t)l * 1024 * AB_IN, (bf16_t*)(p.ws + OFF_WAB_IN) + (size_t)l * AB_INP * 1024, 1024, AB_IN, kb * 64, nb * 32, nb * 32}; return; }
            r -= N_ABIN;
            if (r < N_ABOUT) { const int l = r / I_SQ, q = r % I_SQ, kb = q / 32, nb = q % 32;
                t = TItem{p.ab_w_out + (size_t)l * 1024 * 1024, (bf16_t*)(p.ws + OFF_WAB_OUT) + (size_t)l * 1024 * 1024, 1024, 1024, kb * 64, nb * 32, nb * 32}; return; }
            r -= N_ABOUT;
            if (r < N_CIN) { const int l = r / I_CIN, q = r % I_CIN, kb = q / 48, nb = q % 48;
                const int n0 = nb * 32, pn = n0 >> 8, within = n0 & 255, wc = within >> 6, bj = (within >> 5) & 1;
                t = TItem{p.gqa_w_in + (size_t)l * 1024 * 1536, (bf16_t*)(p.ws + OFF_WC_IN) + (size_t)l * 1536 * 1024, 1024, 1536, kb * 64, n0, pn * 256 + bj * 128 + wc * 32}; return; }
            r -= N_CIN;
            if (r < N_COUT) { const int l = r / I_SQ, q = r % I_SQ, kb = q / 32, nb = q % 32;
                t = TItem{p.gqa_w_out + (size_t)l * 1024 * 1024, (bf16_t*)(p.ws + OFF_WC_OUT) + (size_t)l * 1024 * 1024, 1024, 1024, kb * 64, nb * 32, nb * 32}; return; }
            r -= N_COUT;
            if (r < N_UP) { const int l = r / I_UP, q = r % I_UP, kb = q / 176, nb = q % 176;
                const int n0 = nb * 32; int drow;
                if (n0 < DFF) drow = (n0 >> 7) * 256 + (n0 & 127); else { const int n1 = n0 - DFF; drow = (n1 >> 7) * 256 + 128 + (n1 & 127); }
                t = TItem{p.ffn_w_up + (size_t)l * 1024 * 5632, (bf16_t*)(p.ws + OFF_WUP) + (size_t)l * 5632 * 1024, 1024, 5632, kb * 64, n0, drow}; return; }
            r -= N_UP;
            { const int l = r / I_DN, q = r % I_DN, kb = q / 32, nb = q % 32;
                t = TItem{p.ffn_w_down + (size_t)l * DFF * 1024, (bf16_t*)(p.ws + OFF_WDN) + (size_t)l * 1024 * DFF, DFF, 1024, kb * 64, nb * 32, nb * 32}; }
        };
        TItem cur, nxt; float tvc[32], tvn[32];
        int it = gw;
        if (it < NITEMS) { decode(it, cur); titem_load(cur, tvc, lane); }
        while (it < NITEMS) {
            const int itn = it + NGW;
            if (itn < NITEMS) { decode(itn, nxt); titem_load(nxt, tvn, lane); }
            titem_write(cur, tvc, scr, lane);
            cur = nxt;
#pragma unroll
            for (int i = 0; i < 32; ++i) tvc[i] = tvn[i];
            it = itn;
        }
    }
    __syncthreads();
    {
        LAS float* sT = (LAS float*)lds;
        LAS float* red = (LAS float*)(lds + 49152);
        bool have = false;
        for (int unit = blockIdx.x; unit < 4 * 96; unit += gridDim.x) {
            if (!have) {
                for (int idx = tid; idx < 9 * 1024; idx += 512) { const int v = idx >> 10, k = idx & 1023; const float x = v == 0 ? p.c_ctx[k] : p.c[(v - 1) * 1024 + k]; sT[k * 12 + v] = silu_f(x); }
                have = true;
                __syncthreads();
            }
            const int l = unit / 96, n0 = (unit % 96) * 64, col = tid & 63, kg = tid >> 6;
            const float* wp = p.ada_w + ((size_t)l * 1024 + kg * 128) * 6144 + n0 + col;
            float a[9];
#pragma unroll
            for (int v = 0; v < 9; ++v) a[v] = 0.f;
#pragma unroll 32
            for (int k = 0; k < 128; ++k) {
                const float wv = wp[(size_t)k * 6144];
                const LAS f32x4* sp = (const LAS f32x4*)(sT + (kg * 128 + k) * 12);
                const f32x4 s0 = sp[0], s1 = sp[1], s2 = sp[2];
                a[0] += wv * s0[0]; a[1] += wv * s0[1]; a[2] += wv * s0[2]; a[3] += wv * s0[3];
                a[4] += wv * s1[0]; a[5] += wv * s1[1]; a[6] += wv * s1[2]; a[7] += wv * s1[3]; a[8] += wv * s2[0];
            }
#pragma unroll
            for (int v = 0; v < 9; ++v) red[(kg * 9 + v) * 64 + col] = a[v];
            __syncthreads();
            for (int idx = tid; idx < 576; idx += 512) { const int v = idx >> 6, cc = idx & 63; float s = p.ada_b[l * 6144 + n0 + cc];
#pragma unroll
                for (int q = 0; q < 8; ++q) s += red[(q * 9 + v) * 64 + cc];
                ((float*)(p.ws + OFF_MOD))[(size_t)(l * 9 + v) * 6144 + n0 + cc] = s; }
            __syncthreads();
        }
    }
    const int gtid = blockIdx.x * 512 + tid, gn = gridDim.x * 512;
    for (int idx = gtid; idx < 2048 * 16; idx += gn) {
        const int t = idx >> 4, f = idx & 15;
        const float inv = exp2f(-(float)f * (13.287712379549449f / 16.0f));
        const float ar = (float)(t >> 6) * inv, ac = (float)(t & 63) * inv;
        float* rc = (float*)(p.ws + OFF_ROPE); float* rs = rc + 2048 * 32;
        rc[t * 32 + f] = cosf(ar); rs[t * 32 + f] = sinf(ar); rc[t * 32 + 16 + f] = cosf(ac); rs[t * 32 + 16 + f] = sinf(ac);
    }
    {
        bf16_t* ck = (bf16_t*)(p.ws + OFF_CK_NA); bf16_t* cv = (bf16_t*)(p.ws + OFF_CVT_NA);
        for (int idx = gtid; idx < 2097152 / 2; idx += gn) { const float2 v = ((const float2*)p.cache_na_k)[idx]; ((unsigned*)ck)[idx] = cvt_pk_bf16(v.x, v.y); }
        for (int idx = gtid; idx < 2097152; idx += gn) { const int mat = idx >> 14, r = idx & 16383, d = r >> 8, key = r & 255; cv[idx] = f2bf1(p.cache_na_v[(size_t)mat * 16384 + key * 64 + d]); }
        bf16_t* gk = (bf16_t*)(p.ws + OFF_CK_GQ); bf16_t* gv = (bf16_t*)(p.ws + OFF_CVT_GQ);
        for (int idx = gtid; idx < 1048576 / 2; idx += gn) { const float2 v = ((const float2*)p.cache_gqa_k)[idx]; ((unsigned*)gk)[idx] = cvt_pk_bf16(v.x, v.y); }
        for (int idx = gtid; idx < 1048576; idx += gn) { const int mat = idx >> 14, r = idx & 16383, d = r >> 8, key = r & 255; gv[idx] = f2bf1(p.cache_gqa_v[(size_t)mat * 16384 + key * 64 + d]); }
    }
}

__device__ __forceinline__ void norm_pass(const Params& p, LAS unsigned char* lds, int layer, int which, bool first, const bf16_t* pend, int lr_jl) {
    const int tid0 = opaque_tid(), lane = tid0 & 63, w = tid0 >> 6;
    bf16_t* H = (bf16_t*)(p.ws + OFF_H);
    const float* mod = (const float*)(p.ws + OFF_MOD) + (size_t)layer * 9 * 6144 + which * 3072;
    const float* gw = (which ? p.norm_ffn_g : p.norm_mix_g) + layer * 1024;
    if (lr_jl >= 0) {
        const bf16_t* wl = (const bf16_t*)(p.ws + OFF_WAB_IN) + ((size_t)lr_jl * AB_INP + 3072) * 1024;
#pragma unroll
        for (int it = 0; it < 8; ++it) { const int idx = tid0 + it * 512, n = idx >> 7, pc = idx & 127; *(LAS u32x4*)(lds + n * 2064 + pc * 16) = *(const u32x4*)(wl + (size_t)n * 1024 + pc * 8); }
        __syncthreads();
    }
    const int NGW = gridDim.x * 8;
    f32x4 gv[4];
#pragma unroll
    for (int j = 0; j < 4; ++j) gv[j] = ((const f32x4*)gw)[lane + 64 * j];
    struct Row { f32x4 v[4], sh[4], sc[4]; };
    auto load_row = [&](int m, Row& r) {
        const float* xr = first ? (m < MP ? p.x_prompt + (size_t)m * DM : p.x_sample + (size_t)(m - MP) * DM) : p.out + (size_t)m * DM;
        const float* mv = mod + (size_t)cond_of_row(m) * 6144;
#pragma unroll
        for (int j = 0; j < 4; ++j) r.v[j] = ((const f32x4*)xr)[lane + 64 * j];
#pragma unroll
        for (int j = 0; j < 4; ++j) { r.sh[j] = ((const f32x4*)mv)[lane + 64 * j]; r.sc[j] = ((const f32x4*)(mv + 1024))[lane + 64 * j]; }
        if (pend != nullptr && m >= 16384) {
#pragma unroll
            for (int part = 0; part < 4; ++part)
#pragma unroll
                for (int j = 0; j < 4; ++j) { const u32x2 pw = ((const u32x2*)(pend + ((size_t)part * 4096 + (m - 16384)) * DM))[lane + 64 * j]; r.v[j] = r.v[j] + (f32x4){bflo(pw.x), bfhi(pw.x), bflo(pw.y), bfhi(pw.y)}; }
        }
    };
    Row cur, nxt;
    int m = blockIdx.x * 8 + w;
    if (m < MALL) load_row(m, cur);
    while (m < MALL) {
        const int mn = m + NGW;
        if (mn < MALL) load_row(mn, nxt);
        const bool addp = pend != nullptr && m >= 16384;
        float ss = 0.f;
#pragma unroll
        for (int j = 0; j < 4; ++j) ss += (cur.v[j][0] * cur.v[j][0] + cur.v[j][1] * cur.v[j][1]) + (cur.v[j][2] * cur.v[j][2] + cur.v[j][3] * cur.v[j][3]);
        ss = wave_sum(ss);
        const float rstd = rsqrtf(ss * (1.0f / 1024.0f) + EPS);
#pragma unroll
        for (int j = 0; j < 4; ++j) {
            const int c4 = lane + 64 * j;
            const f32x4 y = cur.v[j] * rstd * gv[j] * (cur.sc[j] + 1.0f) + cur.sh[j];
            u32x2 o; o.x = cvt_pk_bf16(y[0], y[1]); o.y = cvt_pk_bf16(y[2], y[3]);
            *(u32x2*)(H + (size_t)(1 + m) * DM + 4 * c4) = o;
            if (first || addp) ((f32x4*)(p.out + (size_t)m * DM))[c4] = cur.v[j];
        }
        cur = nxt; m = mn;
    }
    if (lr_jl >= 0) {
        asm volatile("s_waitcnt vmcnt(0)" ::: "memory");
        __syncthreads();
        const int fr = lane & 15, fq = lane >> 4, r8 = blockIdx.x * 8;
        bf16_t* qkv = (bf16_t*)(p.ws + OFF_QKV);
        for (int pr = w; r8 + 2 * pr * NGW < MALL; pr += 8) {
            const int m_lo = r8 + 2 * pr * NGW, m_hi = m_lo + NGW;
            const bool has_hi = m_hi < MALL;
            const int mrow = (fr < 8 || !has_hi) ? m_lo + (fr & 7) : m_hi + (fr & 7);
            const bf16_t* arow = H + (size_t)(1 + mrow) * DM + fq * 8;
            f32x4 acc0 = (f32x4){0.f, 0.f, 0.f, 0.f}, acc1 = (f32x4){0.f, 0.f, 0.f, 0.f};
#pragma unroll 8
            for (int ks = 0; ks < 32; ++ks) {
                const bf16x8 a = *(const bf16x8*)(arow + ks * 32);
                const bf16x8 b0 = *(const LAS bf16x8*)(lds + fr * 2064 + (ks * 32 + fq * 8) * 2), b1 = *(const LAS bf16x8*)(lds + (16 + fr) * 2064 + (ks * 32 + fq * 8) * 2);
                acc0 = MFMA16(a, b0, acc0); acc1 = MFMA16(a, b1, acc1);
            }
#pragma unroll
            for (int j = 0; j < 4; ++j) { const int i = 4 * fq + j; if (i < 8 || has_hi) { const int m = i < 8 ? m_lo + i : m_hi + i - 8; bf16_t* o = qkv + (size_t)m * QKVP_AB + 2048 + fr; o[0] = f2bf1(acc0[j]); o[16] = f2bf1(acc1[j]); } }
        }
    }
}
__device__ __forceinline__ void final_norm(const Params& p, const bf16_t* pend) {
    const int tid0 = opaque_tid(), lane = tid0 & 63, w = tid0 >> 6;
    for (int m = blockIdx.x * 8 + w; m < MALL; m += gridDim.x * 8) {
        float* xr = p.out + (size_t)m * DM;
        f32x4 v[4]; float ss = 0.f;
#pragma unroll
        for (int j = 0; j < 4; ++j) v[j] = ((const f32x4*)xr)[lane + 64 * j];
        if (pend != nullptr && m >= 16384) {
#pragma unroll
            for (int part = 0; part < 4; ++part)
#pragma unroll
                for (int j = 0; j < 4; ++j) { const u32x2 w = ((const u32x2*)(pend + ((size_t)part * 4096 + (m - 16384)) * DM))[lane + 64 * j]; v[j] = v[j] + (f32x4){bflo(w.x), bfhi(w.x), bflo(w.y), bfhi(w.y)}; }
        }
#pragma unroll
        for (int j = 0; j < 4; ++j) ss += (v[j][0] * v[j][0] + v[j][1] * v[j][1]) + (v[j][2] * v[j][2] + v[j][3] * v[j][3]);
        ss = wave_sum(ss);
        const float rstd = rsqrtf(ss * (1.0f / 1024.0f) + EPS);
#pragma unroll
        for (int j = 0; j < 4; ++j) { const int c4 = lane + 64 * j; ((f32x4*)xr)[c4] = v[j] * rstd * ((const f32x4*)p.final_g)[c4]; }
    }
}

__device__ __forceinline__ int na_rs(int r) { return min(max(r - 4, 0), 24); }

__device__ __forceinline__ void mixer_ab_phase1(const Params& p, LAS unsigned char* lds, int jl) {
    const int tid = opaque_tid(), lane = tid & 63, w = tid >> 6, fr = lane & 15;
    const bf16_t* qkv = (const bf16_t*)(p.ws + OFF_QKV); const bf16_t* vt = (const bf16_t*)(p.ws + OFF_VT); bf16_t* O = (bf16_t*)(p.ws + OFF_O);
    const bf16_t* ck = (const bf16_t*)(p.ws + OFF_CK_NA); const bf16_t* cv = (const bf16_t*)(p.ws + OFF_CVT_NA);
    constexpr int N_NAS = 8 * 8 * 4, N_NAP = 16 * 8, N_GA = 320 * 4;
    const bool bal = gridDim.x == 256;
    const int nseq = bal ? 7 : (N_NAS + N_NAP + N_GA + (int)gridDim.x - 1) / (int)gridDim.x;
    for (int si = 0; si < nseq; ++si) {
        int unit;
        if (bal) {
            const int x = blockIdx.x & 7, j = blockIdx.x >> 3, bh = x * 8 + (j >> 2), q = j & 3;
            if (si == 0) unit = (bh << 2) + q;
            else if (si == 1) { if (q == 1 || q == 2) continue; unit = N_NAS + bh * 2 + (q == 3 ? 1 : 0); }
            else unit = N_NAS + N_NAP + blockIdx.x + 256 * (si - 2);
        } else { unit = blockIdx.x + si * (int)gridDim.x; if (unit >= N_NAS + N_NAP + N_GA) break; }
        if (unit < N_NAS) {
            const int b = unit >> 5, h = (unit >> 2) & 7, r0 = (unit & 3) * 8;
            const int rlo = na_rs(r0), rhi = na_rs(r0 + 7) + 8, nkt = 4 + (rhi - rlo);
            const int r = r0 + w, myrs = na_rs(r);
            { const float* rp = p.na_rpb + ((size_t)jl * 8 + h) * 465; LAS float* bl = (LAS float*)(lds + AT_BIAS); for (int i = tid; i < 480; i += 512) { const int rr = i >> 5, cc = i & 31; bl[i] = cc < 31 ? rp[rr * 31 + cc] * LOG2E : -INFINITY; } }
            const size_t mat = (size_t)((b * 2 + jl) * 8 + h) * 16384;
            const size_t rowbase = (size_t)MP + (size_t)b * 2048;
            auto tile = [&](int kt, const bf16_t*& kp, int& kpi, const bf16_t*& vp, int& vpi) {
                if (kt < 4) { kp = ck + mat + kt * 64 * 64; kpi = 64; vp = cv + mat + kt * 64; vpi = 256; }
                else { const int kr = rlo + kt - 4; kp = qkv + (rowbase + kr * 64) * QKVP_AB + 512 + h * 64; kpi = QKVP_AB; vp = vt + (size_t)MP * 512 + ((size_t)(b * 8 + h) * 64) * 2048 + kr * 64; vpi = 2048; }
            };
            auto keyrow = [&](int kt) { return kt < 4 ? -1 : rlo + kt - 4; };
            auto active = [&](int kt) { if (kt < 4) return true; const int kr = rlo + kt - 4; return kr >= myrs && kr < myrs + 8; };
            const size_t mq = rowbase + r * 64 + fr;
            flash_unit<true>(lds, nkt, tile, keyrow, active, true, qkv + mq * QKVP_AB + h * 64, (size_t)16 * QKVP_AB, O + mq * DM + h * 64, (size_t)16 * DM, r);
        } else if (unit < N_NAS + N_NAP) {
            const int u2 = unit - N_NAS, b = u2 >> 3, h = u2 & 7;
            auto tile = [&](int kt, const bf16_t*& kp, int& kpi, const bf16_t*& vp, int& vpi) {
                kp = qkv + ((size_t)b * 256 + kt * 64) * QKVP_AB + 512 + h * 64; kpi = QKVP_AB; vp = vt + ((size_t)(b * 8 + h) * 64) * 256 + kt * 64; vpi = 256; };
            auto keyrow = [&](int) { return -1; };
            auto active = [&](int) { return true; };
            const size_t mq = (size_t)b * 256 + 64 * (w & 3) + fr;
            flash_unit<false>(lds, 4, tile, keyrow, active, w < 4, qkv + mq * QKVP_AB + h * 64, (size_t)16 * QKVP_AB, O + mq * DM + h * 64, (size_t)16 * DM, 0);
        } else {
            gla_stepA(p, lds, unit - N_NAS - N_NAP, jl);
        }
    }
}

__device__ __forceinline__ void mixer_c_phase(const Params& p, LAS unsigned char* lds, int jl) {
    const int tid = opaque_tid(), lane = tid & 63, w = tid >> 6, fr = lane & 15;
    const bf16_t* qkv = (const bf16_t*)(p.ws + OFF_QKV); const bf16_t* vt = (const bf16_t*)(p.ws + OFF_VT); bf16_t* O = (bf16_t*)(p.ws + OFF_O);
    const bf16_t* ck = (const bf16_t*)(p.ws + OFF_CK_GQ); const bf16_t* cv = (const bf16_t*)(p.ws + OFF_CVT_GQ);
    constexpr int N_S = 8 * 4 * 16, N_P = 16 * 4 * 4;
    auto keyrow = [&](int) { return -1; };
    auto active = [&](int) { return true; };
    const bool xsw = gridDim.x == 256;
    const int nrounds = xsw ? 3 : (N_S + N_P + (int)gridDim.x - 1) / (int)gridDim.x;
    for (int ri = 0; ri < nrounds; ++ri) {
        int unit;
        if (xsw) { const int x = blockIdx.x & 7, j = blockIdx.x >> 3;
            if (ri < 2) unit = ((x * 2 + (j >> 4) + 16 * ri) << 4) + (j & 15);
            else unit = N_S + ((x * 8 + (j >> 2)) << 2) + (j & 3); }
        else { unit = blockIdx.x + ri * (int)gridDim.x; if (unit >= N_S + N_P) break; }
        if (unit < N_S) {
            const int b = unit >> 6, kvh = (unit >> 4) & 3, qb = unit & 15;
            const size_t mat = (size_t)((b * 2 + jl) * 4 + kvh) * 16384;
            const size_t rowbase = (size_t)MP + (size_t)b * 2048;
            auto tile = [&](int kt, const bf16_t*& kp, int& kpi, const bf16_t*& vp, int& vpi) {
                if (kt < 4) { kp = ck + mat + kt * 64 * 64; kpi = 64; vp = cv + mat + kt * 64; vpi = 256; }
                else { kp = qkv + (rowbase + (kt - 4) * 64) * QKVP_C + 1024 + kvh * 64; kpi = QKVP_C; vp = vt + (size_t)MP * 256 + ((size_t)(b * 4 + kvh) * 64) * 2048 + (kt - 4) * 64; vpi = 2048; }
            };
            const int head = kvh * 4 + (w >> 1);
            const size_t mq = rowbase + qb * 128 + 64 * (w & 1) + fr;
            flash_unit<false>(lds, 36, tile, keyrow, active, true, qkv + mq * QKVP_C + head * 64, (size_t)16 * QKVP_C, O + mq * DM + head * 64, (size_t)16 * DM, 0);
        } else {
            const int u2 = unit - N_S, b = u2 >> 4, kvh = (u2 >> 2) & 3, qb = u2 & 3;
            auto tile = [&](int kt, const bf16_t*& kp, int& kpi, const bf16_t*& vp, int& vpi) {
                kp = qkv + ((size_t)b * 256 + kt * 64) * QKVP_C + 1024 + kvh * 64; kpi = QKVP_C; vp = vt + ((size_t)(b * 4 + kvh) * 64) * 256 + kt * 64; vpi = 256; };
            const int head = kvh * 4 + (w & 3);
            const size_t mq = (size_t)b * 256 + qb * 64 + fr;
            flash_unit<false>(lds, 4, tile, keyrow, active, w < 4, qkv + mq * QKVP_C + head * 64, (size_t)16 * QKVP_C, O + mq * DM + head * 64, (size_t)16 * DM, 0);
        }
    }
}

#define XB_TMO      128
#define XB_XCNT(j)  (256  + 64 * (j))
#define XB_XSUB(j)  (1280 + 64 * (j))
#define XB_XGEN(j)  (2304 + 64 * (j))
#define XB_TOP      3328
#define XB_TOPGEN   3392
#define XCD_BAR_WORDS 3456
#define XB_SPIN_CAP (1u << 18)
__device__ __forceinline__ unsigned xb_ld(unsigned* p)              { return __hip_atomic_load(p, __ATOMIC_RELAXED, __HIP_MEMORY_SCOPE_AGENT); }
__device__ __forceinline__ unsigned xb_add(unsigned* p, unsigned v) { return __hip_atomic_fetch_add(p, v, __ATOMIC_RELAXED, __HIP_MEMORY_SCOPE_AGENT); }
__device__ __forceinline__ unsigned xb_xcc_id() { return (unsigned)__builtin_amdgcn_s_getreg((3 << 11) | 20) & 0xFu; }
#define XB_SPIN(cond, bar) do { unsigned _sp = 0; while (cond) { __builtin_amdgcn_s_sleep(1); \
    if ((++_sp & 255u) == 0u) { if (xb_ld(&(bar)[XB_TMO])) break; if (_sp > XB_SPIN_CAP) { atomicAdd(&(bar)[XB_TMO], 1u); break; } } } } while (0)
struct XcdBarrier { unsigned* bar; unsigned x; volatile LAS unsigned* st; };
__device__ __forceinline__ XcdBarrier xcd_barrier_post(unsigned* bar, volatile LAS unsigned* st) {
    XcdBarrier b; b.bar = bar; b.x = xb_xcc_id(); b.st = st;
    if (threadIdx.x == 0) (void)xb_add(&bar[XB_XCNT(b.x)], 1u);
    return b;
}
__device__ __forceinline__ void xcd_barrier_complete(unsigned* bar, unsigned x, unsigned& nloc, unsigned& nx) {
    const unsigned G = gridDim.x * gridDim.y * gridDim.z;
    unsigned sum, cnt, mine, sp = 0u;
    for (;;) {
        sum = 0u; cnt = 0u; mine = 0u;
#pragma unroll
        for (unsigned j = 0; j < 16; ++j) { const unsigned c = xb_ld(&bar[XB_XCNT(j)]); sum += c; cnt += (c > 0u) ? 1u : 0u; mine = (j == x) ? c : mine; }
        if (sum == G) break;
        __builtin_amdgcn_s_sleep(1);
        if ((++sp & 255u) == 0u) { if (xb_ld(&bar[XB_TMO])) break; if (sp > XB_SPIN_CAP) { atomicAdd(&bar[XB_TMO], 1u); break; } }
    }
    nloc = mine > 0u ? mine : 1u; nx = cnt > 0u ? cnt : 1u;
}
__device__ __forceinline__ void xcd_barrier(const XcdBarrier& b) {
    asm volatile("s_waitcnt vmcnt(0) lgkmcnt(0)" ::: "memory");
    __syncthreads();
    if (threadIdx.x == 0) {
        unsigned* bar = b.bar;
        __builtin_amdgcn_s_waitcnt(0);
        unsigned nloc = b.st[0], nx = b.st[1];
        if (nloc == 0u) { xcd_barrier_complete(bar, b.x, nloc, nx); b.st[0] = nloc; b.st[1] = nx; }
        const unsigned old = xb_add(&bar[XB_XSUB(b.x)], 1u);
        const unsigned gen = old / nloc;
        if (old + 1u == (gen + 1u) * nloc) {
            __builtin_amdgcn_fence(__ATOMIC_RELEASE, "agent");
            asm volatile("s_waitcnt vmcnt(0)" ::: "memory");
            const unsigned og = xb_add(&bar[XB_TOP], 1u);
            const unsigned tg = og / nx;
            if (og + 1u == (tg + 1u) * nx) xb_add(&bar[XB_TOPGEN], 1u);
            else XB_SPIN(xb_ld(&bar[XB_TOPGEN]) == tg, bar);
            __builtin_amdgcn_fence(__ATOMIC_ACQUIRE, "agent");
            xb_add(&bar[XB_XGEN(b.x)], 1u);
            asm volatile("s_waitcnt vmcnt(0)" ::: "memory");
        } else {
            XB_SPIN(xb_ld(&bar[XB_XGEN(b.x)]) == gen, bar);
            __builtin_amdgcn_fence(__ATOMIC_ACQUIRE, "agent");
            asm volatile("s_waitcnt vmcnt(0)" ::: "memory");
        }
    }
    __syncthreads();
}

__global__ void __launch_bounds__(512) mega_fwd(Params p) {
    extern __shared__ __attribute__((aligned(16))) unsigned char lds_raw[];
    LAS unsigned char* lds = (LAS unsigned char*)lds_raw;
    cg::grid_group grid = cg::this_grid();
    volatile LAS unsigned* xst = (volatile LAS unsigned*)(lds + 147440);
    if (threadIdx.x == 0) { xst[0] = 0u; xst[1] = 0u; }
    (void)xcd_barrier_post((unsigned*)p.ws, xst);
#define GSYNC() do { XcdBarrier xb_; xb_.bar = (unsigned*)p.ws; xb_.x = xb_xcc_id(); xb_.st = (volatile LAS unsigned*)(lds + 147440); xcd_barrier(xb_); } while (0)
    const int G = gridDim.x, c = blockIdx.x;
    const float* mod = (const float*)(p.ws + OFF_MOD);
    const bf16_t* H = (const bf16_t*)(p.ws + OFF_H);
    bf16_t* QKV = (bf16_t*)(p.ws + OFF_QKV); bf16_t* VT = (bf16_t*)(p.ws + OFF_VT); bf16_t* VTG = (bf16_t*)(p.ws + OFF_VTG);
    const bf16_t* Ob = (const bf16_t*)(p.ws + OFF_O);
    const bool split = gridDim.x == 256;
    bf16_t* pend_dn = (bf16_t*)(p.ws + OFF_O);
    bf16_t* pend_op = (bf16_t*)(p.ws + OFF_QKV);

#ifndef PM
#define PM 0xffff
#endif
#ifndef DUP
#define DUP 0
#endif
#define REP(bit) for (int rep_ = 0; rep_ < ((DUP & (bit)) ? 2 : 1); ++rep_)
    REP(1) if (PM & 1) prologue(p, lds);
    GSYNC();
    if (p.ws == nullptr) grid.sync();
    for (int layer = 0; layer < 4; ++layer) {
        const int jl = layer >> 1;
        if (PM & 2) norm_pass(p, lds, layer, 0, layer == 0, (layer > 0 && split) ? pend_dn : nullptr, (layer & 1) ? -1 : jl);
        GSYNC();
        if ((layer & 1) == 0) {
            REP(2) if (PM & 4) { pg8::Gemm g{H + DM, (const bf16_t*)(p.ws + OFF_WAB_IN) + (size_t)jl * AB_INP * 1024, MALL, 3072, 1024}; pg8::StaticOrder S; S.init(80, 12, G, c, 16);
              EpiABIn E{QKV, VT, VTG, p.out + OUT_NAK, p.out + OUT_NAV, jl};
              pg8::gemm_phase<EpiABIn, pg8::StaticOrder, true, true, false>(lds, g, S, E); }
            GSYNC();
            REP(4) if (PM & 8) mixer_ab_phase1(p, lds, jl);
            GSYNC();
            if (PM & 16) gla_stepB(p, jl);
            GSYNC();
            REP(4) if (PM & 32) for (int unit = blockIdx.x; unit < 320 * 4; unit += gridDim.x) gla_stepC(p, lds, unit, jl);
            GSYNC();
            if (PM & 64) { pg8::Gemm g{Ob, (const bf16_t*)(p.ws + OFF_WAB_OUT) + (size_t)jl * 1024 * 1024, MALL, 1024, 1024}; pg8::TailSplitOrder S; S.b.init(split ? 64 : 80, 4, G, c, 16); S.split = split;
              EpiRes E{p.out, mod + (size_t)layer * 9 * 6144 + 2048, pend_op};
              pg8::gemm_phase<EpiRes, pg8::TailSplitOrder, true, true, false>(lds, g, S, E); }
        } else {
            REP(2) if (PM & 128) { pg8::Gemm g{H + DM, (const bf16_t*)(p.ws + OFF_WC_IN) + (size_t)jl * 1536 * 1024, MALL, 1536, 1024}; pg8::StaticOrder S; S.init(80, 6, G, c, 16);
              EpiCIn E{QKV, VT, p.out + OUT_GQK, p.out + OUT_GQV, p.qn_g + jl * 64, p.kn_g + jl * 64, (const float*)(p.ws + OFF_ROPE), (const float*)(p.ws + OFF_ROPE) + 2048 * 32, jl};
              pg8::gemm_phase<EpiCIn, pg8::StaticOrder, true, true, false>(lds, g, S, E); }
            GSYNC();
            REP(16) if (PM & 256) mixer_c_phase(p, lds, jl);
            GSYNC();
            if (PM & 64) { pg8::Gemm g{Ob, (const bf16_t*)(p.ws + OFF_WC_OUT) + (size_t)jl * 1024 * 1024, MALL, 1024, 1024}; pg8::TailSplitOrder S; S.b.init(split ? 64 : 80, 4, G, c, 16); S.split = split;
              EpiRes E{p.out, mod + (size_t)layer * 9 * 6144 + 2048, pend_op};
              pg8::gemm_phase<EpiRes, pg8::TailSplitOrder, true, true, false>(lds, g, S, E); }
        }
        GSYNC();
        if (PM & 2) norm_pass(p, lds, layer, 1, false, split ? pend_op : nullptr, -1);
        GSYNC();
        REP(2) if (PM & 512) { pg8::Gemm g{H, (const bf16_t*)(p.ws + OFF_WUP) + (size_t)layer * 5632 * 1024, MALL, 5632, 1024}; pg8::StaticOrder S; S.init(81, 22, G, c, 16);
          EpiUp E{QKV  , p.conv_w + (size_t)layer * 3 * 5632, p.conv_b + (size_t)layer * 5632};
          pg8::Unit uu;
          for (int i = 0; S.next(i, uu); ++i) { OneUnit S1{uu}; pg8::gemm_phase<EpiUp, OneUnit, false, true, true>(lds, g, S1, E); } }
        GSYNC();
        if (PM & 64) { pg8::Gemm g{QKV, (const bf16_t*)(p.ws + OFF_WDN) + (size_t)layer * 1024 * DFF, MALL, 1024, DFF}; pg8::TailSplitOrder S; S.b.init(split ? 64 : 80, 4, G, c, 44); S.split = split;
          EpiRes E{p.out, mod + (size_t)layer * 9 * 6144 + 5120, pend_dn};
          pg8::gemm_phase<EpiRes, pg8::TailSplitOrder, true, true, false>(lds, g, S, E); }
        GSYNC();
    }
    if (PM & 2) final_norm(p, split ? pend_dn : nullptr);

}

extern "C" void kernel_launch(void* const* d_in, const int* in_sizes, int n_in, void* d_out, int out_size, void* d_ws, size_t ws_size, hipStream_t stream) {
    static int grid = 0;
    if (grid == 0) {
        if (n_in != 31 || ws_size < WS_NEED) { fprintf(stderr, "kernel_launch: unexpected n_in %d or ws_size %zu (< %zu)\n", n_in, ws_size, (size_t)WS_NEED); grid = -1; return; }
        int dev = 0, cus = 0, per_cu = 0;
        hipGetDevice(&dev);
        hipDeviceGetAttribute(&cus, hipDeviceAttributeMultiprocessorCount, dev);
        if (hipFuncSetAttribute((const void*)mega_fwd, hipFuncAttributeMaxDynamicSharedMemorySize, LDS_BYTES) != hipSuccess) { fprintf(stderr, "kernel_launch: hipFuncSetAttribute failed\n"); grid = -1; return; }
        hipOccupancyMaxActiveBlocksPerMultiprocessor(&per_cu, (const void*)mega_fwd, 512, LDS_BYTES);
        (void)hipGetLastError();
        if (per_cu < 1) fprintf(stderr, "kernel_launch: occupancy query says %d blocks/CU\n", per_cu);
        grid = cus;
    }
    if (grid < 0) return;
    Params p{};
    const float** pp = (const float**)&p;
    for (int i = 0; i < 31; ++i) pp[i] = (const float*)d_in[i];
    p.out = (float*)d_out; p.ws = (unsigned char*)d_ws;
    (void)hipMemsetAsync(d_ws, 0, 16384, stream);
    void* args[] = {&p};
    hipError_t e = hipLaunchCooperativeKernel((const void*)mega_fwd, dim3(grid), dim3(512), args, LDS_BYTES, stream);
    if (e != hipSuccess) fprintf(stderr, "cooperative launch failed: %s (grid %d)\n", hipGetErrorString(e), grid);
}
```
